# Optimizing an MI355X kernel written in HIP

```python
import math
import jax, jax.numpy as jnp
from jax import lax
import numpy as np

D_MODEL = 1024
BATCH = 8
SEQ = 4096
DEPTH = 1

HEAD_DIM = 64
MLA_HEADS = 8
MLA_Q_RANK = 256
MLA_KV_RANK = 128
MLA_NOPE_DIM = 64
MLA_ROPE_DIM = 32
MLA_V_DIM = HEAD_DIM
ROPE_THETA = 10000.0
DIL_HEADS = 8
DIL_PAIRS = ((128, 1), (512, 4), (2048, 16))
DIL_BLOCK = 128
DIL_WIDTH = DIL_HEADS * HEAD_DIM
MLA_WIDTH = MLA_HEADS * MLA_V_DIM
MIX_WIDTH = MLA_WIDTH + DIL_WIDTH
IN_SPLITS = (MLA_Q_RANK, MLA_KV_RANK, MLA_ROPE_DIM, DIL_WIDTH, DIL_WIDTH, DIL_WIDTH)
IN_WIDTH = sum(IN_SPLITS)
D_FF = 2816
CONV_WIDTH = 3
Q_BLOCK = 128
DN_ALPHA = (2.0 * DEPTH) ** 0.25
DN_BETA = (8.0 * DEPTH) ** -0.25
LN_EPS = 1e-5
RMS_EPS = 1e-6

kernel_name = "hybrid_mla_dilated_swa_convffn_deepnorm"


def layer_norm(x, g, b):
    xf = x.astype(jnp.float32)
    mu = jnp.mean(xf, axis=-1, keepdims=True)
    var = jnp.mean(jnp.square(xf - mu), axis=-1, keepdims=True)
    y = (xf - mu) * lax.rsqrt(var + LN_EPS) * g.astype(jnp.float32) + b.astype(jnp.float32)
    return y.astype(x.dtype)


def rms_norm(x, g):
    xf = x.astype(jnp.float32)
    y = xf * lax.rsqrt(jnp.mean(jnp.square(xf), axis=-1, keepdims=True) + RMS_EPS)
    return (y * g.astype(jnp.float32)).astype(x.dtype)


def apply_rope(x, pos):
    half = x.shape[-1] // 2
    freqs = ROPE_THETA ** (-jnp.arange(half, dtype=jnp.float32) / half)
    ang = pos.astype(jnp.float32)[:, None] * freqs[None, :]
    cos = jnp.cos(ang)[None, :, None, :]
    sin = jnp.sin(ang)[None, :, None, :]
    xf = x.astype(jnp.float32)
    x1, x2 = xf[..., :half], xf[..., half:]
    out = jnp.concatenate([x1 * cos - x2 * sin, x1 * sin + x2 * cos], axis=-1)
    return out.astype(x.dtype)


def alibi_slopes(n):
    return 2.0 ** (-8.0 * jnp.arange(1, n + 1, dtype=jnp.float32) / n)


def mla_attention(c_q, c_kv, k_rope, g_cq, g_ckv, w_uq, w_uk, w_uv):
    B, S, _ = c_q.shape
    pos = jnp.arange(S)
    c_q = rms_norm(c_q, g_cq)
    c_kv = rms_norm(c_kv, g_ckv)
    q = jnp.einsum('bsr,rhe->bshe', c_q, w_uq)
    q_nope, q_rope = q[..., :MLA_NOPE_DIM], q[..., MLA_NOPE_DIM:]
    k_nope = jnp.einsum('bsr,rhe->bshe', c_kv, w_uk)
    v = jnp.einsum('bsr,rhe->bshe', c_kv, w_uv)
    q_rope = apply_rope(q_rope, pos)
    k_rope = apply_rope(k_rope[:, :, None, :], pos)
    qf = jnp.concatenate([q_nope, q_rope], axis=-1)
    kf = jnp.concatenate([k_nope, jnp.broadcast_to(k_rope, k_nope.shape[:3] + (MLA_ROPE_DIM,))], axis=-1)
    scale = 1.0 / math.sqrt(MLA_NOPE_DIM + MLA_ROPE_DIM)
    nb = S // Q_BLOCK
    q_blocks = qf.reshape(B, nb, Q_BLOCK, MLA_HEADS, -1).transpose(1, 0, 2, 3, 4)
    k_pos = jnp.arange(S)

    def one_block(args):
        qb, bi = args
        s = jnp.einsum('bqhe,bkhe->bhqk', qb, kf).astype(jnp.float32) * scale
        q_pos = bi * Q_BLOCK + jnp.arange(Q_BLOCK)
        causal = q_pos[:, None] >= k_pos[None, :]
        s = jnp.where(causal[None, None], s, -jnp.inf)
        p = jax.nn.softmax(s, axis=-1).astype(v.dtype)
        return jnp.einsum('bhqk,bkhe->bqhe', p, v)

    o = lax.map(one_block, (q_blocks, jnp.arange(nb)))
    return o.transpose(1, 0, 2, 3, 4).reshape(B, S, MLA_HEADS * MLA_V_DIM)


def dilated_branch(q, k, v, slopes, window, dil):
    B, S, H, E = q.shape
    n_back = window // dil
    blk = DIL_BLOCK
    L = -(-S // (dil * blk)) * dil * blk
    M = L // dil
    nb = M // blk

    def to_sub(a):
        a = jnp.pad(a, ((0, 0), (0, L - S), (0, 0), (0, 0)))
        a = a.reshape(B, M, dil, H, E).transpose(0, 2, 1, 3, 4)
        return a.reshape(B, dil, nb, blk, H, E)

    def with_prev(ab):
        prev = jnp.pad(ab, ((0, 0), (0, 0), (1, 0), (0, 0), (0, 0), (0, 0)))[:, :, :-1]
        return jnp.concatenate([prev, ab], axis=3)

    qb = to_sub(q)
    kb = with_prev(to_sub(k))
    vb = with_prev(to_sub(v))
    s = jnp.einsum('bdnqhe,bdnkhe->bdnhqk', qb, kb).astype(jnp.float32) / math.sqrt(E)
    jq = jnp.arange(nb)[:, None] * blk + jnp.arange(blk)[None, :]
    jk = jnp.arange(nb)[:, None] * blk - blk + jnp.arange(2 * blk)[None, :]
    off = jq[:, :, None] - jk[:, None, :]
    valid = (off >= 0) & (off <= n_back) & (jk[:, None, :] >= 0)
    dist = (off * dil).astype(jnp.float32)
    bias = -slopes[None, :, None, None] * dist[:, None]
    s = jnp.where(valid[:, None], s + bias, -jnp.inf)
    lse = jax.nn.logsumexp(s, axis=-1)
    p = jnp.exp(s - lse[..., None]).astype(v.dtype)
    o = jnp.einsum('bdnhqk,bdnkhe->bdnqhe', p, vb)
    o = o.reshape(B, dil, M, H, E).transpose(0, 2, 1, 3, 4).reshape(B, L, H, E)[:, :S]
    lse = lse.transpose(0, 1, 2, 4, 3).reshape(B, dil, M, H).transpose(0, 2, 1, 3).reshape(B, L, H)[:, :S]
    return o, lse


def dilated_attention(q, k, v):
    B, S, H, E = q.shape
    slopes = alibi_slopes(H)
    outs, lses = [], []
    for window, dil in DIL_PAIRS:
        o, lse = dilated_branch(q, k, v, slopes, window, dil)
        outs.append(o.astype(jnp.float32))
        lses.append(lse)
    w = jax.nn.softmax(jnp.stack(lses, axis=0), axis=0)
    o = jnp.sum(w[..., None] * jnp.stack(outs, axis=0), axis=0)
    return o.astype(q.dtype).reshape(B, S, H * E)


def conv_gated_ffn(x, w_up, conv_w, conv_b, w_down):
    S = x.shape[1]
    u = x @ w_up
    y = conv_b
    for j in range(CONV_WIDTH):
        shift = CONV_WIDTH - 1 - j
        us = jnp.pad(u, ((0, 0), (shift, 0), (0, 0)))[:, :S] if shift else u
        y = y + conv_w[j] * us
    a, g = y[..., :D_FF], y[..., D_FF:]
    return (jax.nn.gelu(g) * a) @ w_down


def setup_inputs(seed: int = 0) -> dict:
    key = jax.random.key(seed)
    ks = jax.random.split(key, 17)
    f32 = jnp.float32
    x = jax.random.normal(ks[0], (BATCH, SEQ, D_MODEL), f32)
    col_scale = jnp.concatenate([jnp.ones((IN_WIDTH - DIL_WIDTH,), f32),
                                 jnp.full((DIL_WIDTH,), DN_BETA, f32)])
    w_in = jax.random.normal(ks[1], (D_MODEL, IN_WIDTH), f32) * D_MODEL ** -0.5 * col_scale
    g_cq = 1.0 + 0.02 * jax.random.normal(ks[2], (MLA_Q_RANK,), f32)
    g_ckv = 1.0 + 0.02 * jax.random.normal(ks[3], (MLA_KV_RANK,), f32)
    w_uq = jax.random.normal(ks[4], (MLA_Q_RANK, MLA_HEADS, MLA_NOPE_DIM + MLA_ROPE_DIM), f32) * MLA_Q_RANK ** -0.5
    w_uk = jax.random.normal(ks[5], (MLA_KV_RANK, MLA_HEADS, MLA_NOPE_DIM), f32) * MLA_KV_RANK ** -0.5
    w_uv = jax.random.normal(ks[6], (MLA_KV_RANK, MLA_HEADS, MLA_V_DIM), f32) * MLA_KV_RANK ** -0.5 * DN_BETA
    w_o = jax.random.normal(ks[7], (MIX_WIDTH, D_MODEL), f32) * MIX_WIDTH ** -0.5 * DN_BETA
    ln1_g = 1.0 + 0.02 * jax.random.normal(ks[8], (D_MODEL,), f32)
    ln1_b = 0.02 * jax.random.normal(ks[9], (D_MODEL,), f32)
    w_up = jax.random.normal(ks[10], (D_MODEL, 2 * D_FF), f32) * D_MODEL ** -0.5 * DN_BETA
    conv_w = jax.random.normal(ks[11], (CONV_WIDTH, 2 * D_FF), f32) * CONV_WIDTH ** -0.5
    conv_b = 0.01 * jax.random.normal(ks[12], (2 * D_FF,), f32)
    w_down = jax.random.normal(ks[13], (D_FF, D_MODEL), f32) * D_FF ** -0.5 * DN_BETA
    ln2_g = 1.0 + 0.02 * jax.random.normal(ks[14], (D_MODEL,), f32)
    ln2_b = 0.02 * jax.random.normal(ks[15], (D_MODEL,), f32)
    return {"x": x, "w_in": w_in, "g_cq": g_cq, "g_ckv": g_ckv, "w_uq": w_uq,
            "w_uk": w_uk, "w_uv": w_uv, "w_o": w_o, "ln1_g": ln1_g, "ln1_b": ln1_b,
            "w_up": w_up, "conv_w": conv_w, "conv_b": conv_b, "w_down": w_down,
            "ln2_g": ln2_g, "ln2_b": ln2_b}


def reference(x, w_in, g_cq, g_ckv, w_uq, w_uk, w_uv, w_o, ln1_g, ln1_b,
              w_up, conv_w, conv_b, w_down, ln2_g, ln2_b):
    B, S, _ = x.shape
    for _layer in range(DEPTH):
        h = x @ w_in
        idx = np.cumsum(IN_SPLITS)[:-1].tolist()
        c_q, c_kv, k_rope, q_d, k_d, v_d = jnp.split(h, idx, axis=-1)
        o_mla = mla_attention(c_q, c_kv, k_rope, g_cq, g_ckv, w_uq, w_uk, w_uv)
        o_dil = dilated_attention(q_d.reshape(B, S, DIL_HEADS, HEAD_DIM),
                                  k_d.reshape(B, S, DIL_HEADS, HEAD_DIM),
                                  v_d.reshape(B, S, DIL_HEADS, HEAD_DIM))
        mix = jnp.concatenate([o_mla, o_dil], axis=-1) @ w_o
        x = layer_norm(DN_ALPHA * x + mix, ln1_g, ln1_b)
        ffn = conv_gated_ffn(x, w_up, conv_w, conv_b, w_down)
        x = layer_norm(DN_ALPHA * x + ffn, ln2_g, ln2_b)
    return x
```

```cpp
#include <hip/hip_runtime.h>
#include <cstdio>
#include <cstdint>
#include <cmath>

namespace nv {
constexpr int B_ = 8, S_ = 4096, DM = 1024, M_ = B_ * S_;
constexpr int INW = 1952, FF = 2816;
constexpr float LN_EPS = 1e-5f, RMS_EPS = 1e-6f;
constexpr float DN_ALPHA = 1.189207115002721f;

__global__ __launch_bounds__(256) void sgemm(const float* __restrict__ A, int lda, const float* __restrict__ Bm, int ldb, float* __restrict__ C, int ldc, int M, int N, int K) {
    __shared__ float As[16][68];
    __shared__ float Bs[16][68];
    const int t = threadIdx.x, m0 = blockIdx.y * 64, n0 = blockIdx.x * 64;
    const int ty = t >> 4, tx = t & 15;
    float acc[4][4];
#pragma unroll
    for (int i = 0; i < 4; ++i)
#pragma unroll
        for (int j = 0; j < 4; ++j) acc[i][j] = 0.f;
    const int ar = t >> 2, ak = (t & 3) * 4;
    const int bk = t >> 4, bn = (t & 15) * 4;
    for (int k0 = 0; k0 < K; k0 += 16) {
        const float4 av = *(const float4*)(A + (size_t)(m0 + ar) * lda + k0 + ak);
        float4 bv = make_float4(0.f, 0.f, 0.f, 0.f);
        if (n0 + bn < N) bv = *(const float4*)(Bm + (size_t)(k0 + bk) * ldb + n0 + bn);
        __syncthreads();
        As[ak + 0][ar] = av.x; As[ak + 1][ar] = av.y; As[ak + 2][ar] = av.z; As[ak + 3][ar] = av.w;
        Bs[bk][bn + 0] = bv.x; Bs[bk][bn + 1] = bv.y; Bs[bk][bn + 2] = bv.z; Bs[bk][bn + 3] = bv.w;
        __syncthreads();
#pragma unroll
        for (int kk = 0; kk < 16; ++kk) {
            float a[4], b[4];
#pragma unroll
            for (int i = 0; i < 4; ++i) a[i] = As[kk][ty * 4 + i];
#pragma unroll
            for (int j = 0; j < 4; ++j) b[j] = Bs[kk][tx * 4 + j];
#pragma unroll
            for (int i = 0; i < 4; ++i)
#pragma unroll
                for (int j = 0; j < 4; ++j) acc[i][j] = fmaf(a[i], b[j], acc[i][j]);
        }
    }
#pragma unroll
    for (int i = 0; i < 4; ++i) {
        const int r = m0 + ty * 4 + i;
#pragma unroll
        for (int j = 0; j < 4; ++j) { const int c = n0 + tx * 4 + j; if (c < N) C[(size_t)r * ldc + c] = acc[i][j]; }
    }
}

__device__ __forceinline__ float wsum(float v) {
#pragma unroll
    for (int o = 1; o < 64; o <<= 1) v += __shfl_xor(v, o);
    return v;
}

__global__ __launch_bounds__(256) void mla_prep(const float* __restrict__ h, const float* __restrict__ gq, const float* __restrict__ gkv, float* __restrict__ cqn, float* __restrict__ ckvn, float* __restrict__ kr) {
    const int row = blockIdx.x * 4 + (threadIdx.x >> 6), lane = threadIdx.x & 63;
    const float* hr = h + (size_t)row * INW;
    float v[4]; float s = 0.f;
#pragma unroll
    for (int j = 0; j < 4; ++j) { v[j] = hr[lane + 64 * j]; s += v[j] * v[j]; }
    s = wsum(s); const float rq = 1.0f / sqrtf(s * (1.f / 256.f) + RMS_EPS);
#pragma unroll
    for (int j = 0; j < 4; ++j) cqn[(size_t)row * 256 + lane + 64 * j] = v[j] * rq * gq[lane + 64 * j];
    float w[2]; float s2 = 0.f;
#pragma unroll
    for (int j = 0; j < 2; ++j) { w[j] = hr[256 + lane + 64 * j]; s2 += w[j] * w[j]; }
    s2 = wsum(s2); const float rk = 1.0f / sqrtf(s2 * (1.f / 128.f) + RMS_EPS);
#pragma unroll
    for (int j = 0; j < 2; ++j) ckvn[(size_t)row * 128 + lane + 64 * j] = w[j] * rk * gkv[lane + 64 * j];
    if (lane < 16) {
        const int pos = row % S_;
        const float fr = powf(10000.0f, -(float)lane / 16.0f);
        const float ang = (float)pos * fr;
        const float c = cosf(ang), sn = sinf(ang);
        const float x1 = hr[384 + lane], x2 = hr[384 + 16 + lane];
        kr[(size_t)row * 32 + lane] = x1 * c - x2 * sn;
        kr[(size_t)row * 32 + 16 + lane] = x1 * sn + x2 * c;
    }
}

__global__ __launch_bounds__(256) void q_rope(float* __restrict__ q) {
    const size_t idx = (size_t)blockIdx.x * 256 + threadIdx.x;
    const int i = idx & 15; const int hh = (idx >> 4) & 7; const size_t row = idx >> 7;
    const int pos = (int)(row % S_);
    const float fr = powf(10000.0f, -(float)i / 16.0f);
    const float ang = (float)pos * fr;
    const float c = cosf(ang), sn = sinf(ang);
    float* p = q + row * 768 + hh * 96 + 64;
    const float x1 = p[i], x2 = p[16 + i];
    p[i] = x1 * c - x2 * sn; p[16 + i] = x1 * sn + x2 * c;
}

__global__ __launch_bounds__(256) void mla_attn(const float* __restrict__ q, const float* __restrict__ kn, const float* __restrict__ kr, const float* __restrict__ v, float* __restrict__ concat) {
    const int qb = blockIdx.x & 15, hh = (blockIdx.x >> 4) & 7, b = blockIdx.x >> 7;
    const int qi = qb * 256 + threadIdx.x;
    const size_t row = (size_t)b * S_ + qi;
    float qv[96];
#pragma unroll
    for (int e = 0; e < 96; ++e) qv[e] = q[row * 768 + hh * 96 + e];
    float o[64];
#pragma unroll
    for (int e = 0; e < 64; ++e) o[e] = 0.f;
    float m = -INFINITY, l = 0.f;
    const float scale = 0.10206207261596577f;
    const int jmax = qb * 256 + 255;
    for (int j = 0; j <= jmax; ++j) {
        const size_t kr_ = (size_t)b * S_ + j;
        const float* kp = kn + kr_ * 512 + hh * 64;
        const float* rp = kr + kr_ * 32;
        float s = 0.f;
#pragma unroll
        for (int e = 0; e < 64; ++e) s = fmaf(qv[e], kp[e], s);
#pragma unroll
        for (int e = 0; e < 32; ++e) s = fmaf(qv[64 + e], rp[e], s);
        s *= scale;
        if (j <= qi) {
            if (s > m) {
                const float corr = expf(m - s);
                l *= corr;
#pragma unroll
                for (int e = 0; e < 64; ++e) o[e] *= corr;
                m = s;
            }
            const float p = expf(s - m);
            l += p;
            const float* vp = v + kr_ * 512 + hh * 64;
#pragma unroll
            for (int e = 0; e < 64; ++e) o[e] = fmaf(p, vp[e], o[e]);
        }
    }
    const float inv = 1.0f / l;
#pragma unroll
    for (int e = 0; e < 64; ++e) concat[row * 1024 + hh * 64 + e] = o[e] * inv;
}

__global__ __launch_bounds__(256) void dil_attn(const float* __restrict__ h, float* __restrict__ concat) {
    const int qb = blockIdx.x & 15, hh = (blockIdx.x >> 4) & 7, b = blockIdx.x >> 7;
    const int t = qb * 256 + threadIdx.x;
    const size_t row = (size_t)b * S_ + t;
    float qv[64];
#pragma unroll
    for (int e = 0; e < 64; ++e) qv[e] = h[row * INW + 416 + hh * 64 + e];
    const float slope = exp2f(-(float)(hh + 1));
    float oc[64];
#pragma unroll
    for (int e = 0; e < 64; ++e) oc[e] = 0.f;
    float mc = -INFINITY, lc = 0.f;
    for (int p = 0; p < 3; ++p) {
        const int dil = (p == 0) ? 1 : (p == 1) ? 4 : 16;
        float o[64];
#pragma unroll
        for (int e = 0; e < 64; ++e) o[e] = 0.f;
        float m = -INFINITY, l = 0.f;
        for (int off = 0; off <= 128; ++off) {
            const int tk = t - off * dil;
            if (tk < 0) break;
            const size_t krow = (size_t)b * S_ + tk;
            const float* kp = h + krow * INW + 928 + hh * 64;
            float s = 0.f;
#pragma unroll
            for (int e = 0; e < 64; ++e) s = fmaf(qv[e], kp[e], s);
            s = s * 0.125f - slope * (float)(off * dil);
            if (s > m) {
                const float corr = expf(m - s);
                l *= corr;
#pragma unroll
                for (int e = 0; e < 64; ++e) o[e] *= corr;
                m = s;
            }
            const float pr = expf(s - m);
            l += pr;
            const float* vp = h + krow * INW + 1440 + hh * 64;
#pragma unroll
            for (int e = 0; e < 64; ++e) o[e] = fmaf(pr, vp[e], o[e]);
        }
        const float lse = m + logf(l);
        const float mn = fmaxf(mc, lse);
        const float c0 = expf(mc - mn), c1 = expf(lse - mn);
        const float il = 1.0f / l;
#pragma unroll
        for (int e = 0; e < 64; ++e) oc[e] = oc[e] * c0 + c1 * (o[e] * il);
        lc = lc * c0 + c1; mc = mn;
    }
    const float inv = 1.0f / lc;
#pragma unroll
    for (int e = 0; e < 64; ++e) concat[row * 1024 + 512 + hh * 64 + e] = oc[e] * inv;
}

__global__ __launch_bounds__(256) void ln_res(const float* xin, const float* __restrict__ add, const float* __restrict__ g, const float* __restrict__ bb, float* out) {
    const int row = blockIdx.x * 4 + (threadIdx.x >> 6), lane = threadIdx.x & 63;
    const float4* xr = (const float4*)(xin + (size_t)row * DM) + lane;
    const float4* ar = (const float4*)(add + (size_t)row * DM) + lane;
    float4 v[4]; float s = 0.f;
#pragma unroll
    for (int j = 0; j < 4; ++j) { const float4 a = xr[64 * j], c = ar[64 * j]; v[j] = make_float4(DN_ALPHA * a.x + c.x, DN_ALPHA * a.y + c.y, DN_ALPHA * a.z + c.z, DN_ALPHA * a.w + c.w); s += (v[j].x + v[j].y) + (v[j].z + v[j].w); }
    const float mean = wsum(s) * (1.f / DM); float s2 = 0.f;
#pragma unroll
    for (int j = 0; j < 4; ++j) { v[j].x -= mean; v[j].y -= mean; v[j].z -= mean; v[j].w -= mean; s2 += (v[j].x * v[j].x + v[j].y * v[j].y) + (v[j].z * v[j].z + v[j].w * v[j].w); }
    const float rstd = 1.0f / sqrtf(wsum(s2) * (1.f / DM) + LN_EPS);
    float4* orow = (float4*)(out + (size_t)row * DM) + lane;
#pragma unroll
    for (int j = 0; j < 4; ++j) { const float4 gg = ((const float4*)g)[lane + 64 * j], be = ((const float4*)bb)[lane + 64 * j];
        orow[64 * j] = make_float4(v[j].x * rstd * gg.x + be.x, v[j].y * rstd * gg.y + be.y, v[j].z * rstd * gg.z + be.z, v[j].w * rstd * gg.w + be.w); }
}

__device__ __forceinline__ float gelu_tanh(float x) { const float u = 0.7978845608028654f * (x + 0.044715f * x * x * x); return 0.5f * x * (1.0f + tanhf(u)); }

__global__ __launch_bounds__(256) void conv_gate(const float* __restrict__ ua, const float* __restrict__ ug, int CW, int c0, const float* __restrict__ cw, const float* __restrict__ cb, float* __restrict__ act) {
    const size_t idx = (size_t)blockIdx.x * 256 + threadIdx.x;
    const int c = (int)(idx % CW); const size_t row = idx / CW;
    const int t = (int)(row % S_);
    float ya = cb[c0 + c], yg = cb[FF + c0 + c];
#pragma unroll
    for (int j = 0; j < 3; ++j) {
        const int sh = 2 - j;
        if (t - sh >= 0) { ya = fmaf(cw[j * 2 * FF + c0 + c], ua[(row - sh) * CW + c], ya); yg = fmaf(cw[j * 2 * FF + FF + c0 + c], ug[(row - sh) * CW + c], yg); }
    }
    act[row * FF + c0 + c] = gelu_tanh(yg) * ya;
}

static void gemm(hipStream_t st, const float* A, int lda, const float* Bm, int ldb, float* C, int ldc, int M, int N, int K) {
    dim3 g((N + 63) / 64, M / 64);
    hipLaunchKernelGGL(sgemm, g, dim3(256), 0, st, A, lda, Bm, ldb, C, ldc, M, N, K);
}
}

extern "C" void kernel_launch(void* const* d_in, const int* in_sizes, int n_in, void* d_out, int out_size, void* d_ws, size_t ws_size, hipStream_t stream) {
    using namespace nv;
    constexpr size_t MiB = 1u << 20;
    if (n_in != 16 || ws_size < 512 * MiB) { fprintf(stderr, "kernel_launch: unexpected n_in %d / ws %zu\n", n_in, ws_size); return; }
    const float* x = (const float*)d_in[0]; const float* w_in = (const float*)d_in[1]; const float* g_cq = (const float*)d_in[2]; const float* g_ckv = (const float*)d_in[3];
    const float* w_uq = (const float*)d_in[4]; const float* w_uk = (const float*)d_in[5]; const float* w_uv = (const float*)d_in[6]; const float* w_o = (const float*)d_in[7];
    const float* ln1_g = (const float*)d_in[8]; const float* ln1_b = (const float*)d_in[9]; const float* w_up = (const float*)d_in[10]; const float* conv_w = (const float*)d_in[11];
    const float* conv_b = (const float*)d_in[12]; const float* w_down = (const float*)d_in[13]; const float* ln2_g = (const float*)d_in[14]; const float* ln2_b = (const float*)d_in[15];
    char* ws = (char*)d_ws; float* out = (float*)d_out;
    float* H = (float*)(ws + 0);
    float* CONCAT = (float*)(ws + 256 * MiB);
    float* CQN = (float*)(ws + 384 * MiB);
    float* CKVN = (float*)(ws + 416 * MiB);
    float* KR = (float*)(ws + 432 * MiB);
    float* Q = (float*)(ws + 0);
    float* KN = (float*)(ws + 96 * MiB);
    float* V = (float*)(ws + 160 * MiB);
    float* MIX = (float*)(ws + 0);
    float* ACT = (float*)(ws + 0);
    float* UA = (float*)(ws + 352 * MiB);
    float* UG = (float*)(ws + 396 * MiB);
    float* FFN = (float*)(ws + 352 * MiB);
    gemm(stream, x, DM, w_in, INW, H, INW, M_, INW, DM);
    hipLaunchKernelGGL(dil_attn, dim3(B_ * 8 * 16), dim3(256), 0, stream, H, CONCAT);
    hipLaunchKernelGGL(mla_prep, dim3(M_ / 4), dim3(256), 0, stream, H, g_cq, g_ckv, CQN, CKVN, KR);
    gemm(stream, CQN, 256, w_uq, 768, Q, 768, M_, 768, 256);
    hipLaunchKernelGGL(q_rope, dim3(M_ * 8 * 16 / 256), dim3(256), 0, stream, Q);
    gemm(stream, CKVN, 128, w_uk, 512, KN, 512, M_, 512, 128);
    gemm(stream, CKVN, 128, w_uv, 512, V, 512, M_, 512, 128);
    hipLaunchKernelGGL(mla_attn, dim3(B_ * 8 * 16), dim3(256), 0, stream, Q, KN, KR, V, CONCAT);
    gemm(stream, CONCAT, DM, w_o, DM, MIX, DM, M_, DM, DM);
    hipLaunchKernelGGL(ln_res, dim3(M_ / 4), dim3(256), 0, stream, x, MIX, ln1_g, ln1_b, out);
    for (int c = 0; c < 8; ++c) {
        const int c0 = c * 352;
        gemm(stream, out, DM, w_up + c0, 2 * FF, UA, 352, M_, 352, DM);
        gemm(stream, out, DM, w_up + FF + c0, 2 * FF, UG, 352, M_, 352, DM);
        hipLaunchKernelGGL(conv_gate, dim3((unsigned)((size_t)M_ * 352 / 256)), dim3(256), 0, stream, UA, UG, 352, c0, conv_w, conv_b, ACT);
    }
    gemm(stream, ACT, FF, w_down, DM, FFN, DM, M_, DM, FF);
    hipLaunchKernelGGL(ln_res, dim3(M_ / 4), dim3(256), 0, stream, out, FFN, ln2_g, ln2_b, out);
}
```

```cpp
#include <hip/hip_runtime.h>
#include <hip/hip_bf16.h>
#include <cstdio>
#include <cstdint>
#include <cmath>
namespace pg8 {
#define PG8_LAS __attribute__((address_space(3)))
typedef unsigned short bf16_t;
typedef short bf16x8 __attribute__((ext_vector_type(8)));
typedef float f32x4 __attribute__((ext_vector_type(4)));
typedef float f32x2 __attribute__((ext_vector_type(2)));
typedef unsigned u32x4 __attribute__((ext_vector_type(4)));
typedef unsigned u32x2 __attribute__((ext_vector_type(2)));
constexpr int BM = 256, BK = 64, HALF = 128, HTB = HALF * BK * 2  , STAGE_BYTES = 8 * HTB, NXCD = 8, WGM = 8;

__host__ __device__ __forceinline__ int lds_byte(int r, int c) { const int st = (r >> 4) * 2 + (c >> 5), rr = r & 15, cc = c & 31, ob = rr * 64 + cc * 2; return st * 1024 + (ob ^ (((ob >> 9) & 1) << 5)); }
__host__ __device__ __forceinline__ void stage_rc(int b, int& R, int& C) { const int st = b / 1024, sb = b % 1024, swz = sb ^ (((sb >> 9) & 1) << 5); R = (st >> 1) * 16 + swz / 64; C = (st & 1) * 32 + (swz % 64) / 2; }
__host__ __device__ __forceinline__ int perm32(int rho) { const int n = rho >> 4, i = rho & 15; return 8 * (i >> 2) + 4 * n + (i & 3); }

struct Unit { int pm, pn; };
struct Gemm { const bf16_t* A; const bf16_t* Bt; int M, N, K, lda, ldb; };

struct StaticOrder {
    int nM, nN, nwg, G, c;
    __host__ __device__ void init(int M, int N, int G_, int c_) { nM = M / BM; nN = N / BM; nwg = nM * nN; G = G_; c = c_; }
    __host__ __device__ bool next(int i, Unit& u) const {
        const long L = (long)i * G + c; if (L >= nwg) return false;
        int wgid = (int)L; { const int q = nwg / NXCD, r = nwg % NXCD, xcd = wgid % NXCD, off = wgid / NXCD; wgid = (xcd < r ? xcd * (q + 1) : r * (q + 1) + (xcd - r) * q) + off; }
        const int nig = WGM * nN, gid = wgid / nig, fm = gid * WGM, gsz = (nM - fm) < WGM ? (nM - fm) : WGM;
        u.pm = fm + ((wgid % nig) % gsz); u.pn = (wgid % nig) / gsz; return true;
    }
};

__device__ __forceinline__ unsigned cvt_pk_bf16(float lo, float hi) { unsigned r; asm volatile("v_cvt_pk_bf16_f32 %0, %1, %2" : "=v"(r) : "v"(lo), "v"(hi)); return r; }
__device__ __forceinline__ u32x4 pack8(const f32x4 v0, const f32x4 v1) { u32x4 w; w.x = cvt_pk_bf16(v0[0], v0[1]); w.y = cvt_pk_bf16(v0[2], v0[3]); w.z = cvt_pk_bf16(v1[0], v1[1]); w.w = cvt_pk_bf16(v1[2], v1[3]); return w; }


struct EpiStoreBf16 {
    static constexpr bool PERM = true, AFTER_DRAIN = false;
    bf16_t* O; int ldc;
    __device__ __forceinline__ void operator()(const f32x4 (&acc)[2][2][4][2], const Unit& u, int wr, int wc, int fr, int fq) const {
        const int row0 = u.pm * BM + wr * 64 + fr, col0 = u.pn * BM + wc * 32 + 8 * fq;
#pragma unroll
        for (int ai = 0; ai < 2; ++ai)
#pragma unroll
            for (int m = 0; m < 4; ++m) { bf16_t* rowp = O + (size_t)(row0 + ai * HALF + m * 16) * ldc + col0;
#pragma unroll
                for (int bj = 0; bj < 2; ++bj) *(u32x4*)(rowp + bj * HALF) = pack8(acc[ai][bj][m][0], acc[ai][bj][m][1]); }
    }
};
struct EpiStoreF32 {
    static constexpr bool PERM = false, AFTER_DRAIN = false;
    float* O; int ldc;
    __device__ __forceinline__ void operator()(const f32x4 (&acc)[2][2][4][2], const Unit& u, int wr, int wc, int fr, int fq) const {
        const int row0 = u.pm * BM + wr * 64 + fr, col0 = u.pn * BM + wc * 32 + 4 * fq;
#pragma unroll
        for (int ai = 0; ai < 2; ++ai)
#pragma unroll
            for (int m = 0; m < 4; ++m) { float* rowp = O + (size_t)(row0 + ai * HALF + m * 16) * ldc + col0;
#pragma unroll
                for (int bj = 0; bj < 2; ++bj)
#pragma unroll
                    for (int n = 0; n < 2; ++n) *(f32x4*)(rowp + bj * HALF + n * 16) = acc[ai][bj][m][n]; }
    }
};
struct EpiH {
    static constexpr bool PERM = true, AFTER_DRAIN = false;
    bf16_t *CQ, *CKV, *QD, *KD, *VD; float *partq, *partkv; float qscale;
    __device__ __forceinline__ void operator()(const f32x4 (&acc)[2][2][4][2], const Unit& u, int wr, int wc, int fr, int fq) const {
        const int pn = u.pn;
        bf16_t* base; int ldc, colt; float sc = 1.f;
        if (pn == 0) { base = CQ; ldc = 256; colt = 0; }
        else if (pn == 1) { base = CKV; ldc = 256; colt = 0; }
        else if (pn < 4) { base = QD; ldc = 512; colt = (pn - 2) * 256; sc = qscale; }
        else if (pn < 6) { base = KD; ldc = 512; colt = (pn - 4) * 256; }
        else { base = VD; ldc = 512; colt = (pn - 6) * 256; }
        const int row0 = u.pm * BM + wr * 64 + fr, col0 = colt + wc * 32 + 8 * fq;
#pragma unroll
        for (int ai = 0; ai < 2; ++ai)
#pragma unroll
            for (int m = 0; m < 4; ++m) { bf16_t* rowp = base + (size_t)(row0 + ai * HALF + m * 16) * ldc + col0;
#pragma unroll
                for (int bj = 0; bj < 2; ++bj) *(u32x4*)(rowp + bj * HALF) = pack8(acc[ai][bj][m][0] * sc, acc[ai][bj][m][1] * sc); }
        if (pn <= 1) {
            float* part = pn == 0 ? partq : partkv;
#pragma unroll
            for (int ai = 0; ai < 2; ++ai)
#pragma unroll
                for (int m = 0; m < 4; ++m) {
                    float s = 0.f;
#pragma unroll
                    for (int n = 0; n < 2; ++n) { const f32x4 x = acc[ai][0][m][n]; s += (x[0] * x[0] + x[1] * x[1]) + (x[2] * x[2] + x[3] * x[3]); }
                    if (pn == 0) {
#pragma unroll
                        for (int n = 0; n < 2; ++n) { const f32x4 x = acc[ai][1][m][n]; s += (x[0] * x[0] + x[1] * x[1]) + (x[2] * x[2] + x[3] * x[3]); }
                    }
                    s += __shfl_xor(s, 16); s += __shfl_xor(s, 32);
                    if (fq == 0) part[(size_t)(row0 + ai * HALF + m * 16) * 4 + wc] = s;
                }
        }
    }
};
struct EpiQ {
    static constexpr bool PERM = true, AFTER_DRAIN = false;
    bf16_t* QM; const float* partq; const float* rope; float c2m; float eps;
    __device__ __forceinline__ void operator()(const f32x4 (&acc)[2][2][4][2], const Unit& u, int wr, int wc, int fr, int fq) const {
        const int row0 = u.pm * BM + wr * 64 + fr, col0 = u.pn * BM + wc * 32 + 8 * fq;
        const bool up = fq >= 2;
        const float sg = up ? 1.f : -1.f;
#pragma unroll
        for (int ai = 0; ai < 2; ++ai)
#pragma unroll
            for (int m = 0; m < 4; ++m) {
                const int row = row0 + ai * HALF + m * 16;
                const f32x4 pq = *(const f32x4*)(partq + (size_t)row * 4);
                const float rs = c2m * __builtin_amdgcn_rsqf(((pq[0] + pq[1]) + (pq[2] + pq[3])) * (1.f / 256.f) + eps);
                const int pos = row & 4095;
                bf16_t* rowp = QM + (size_t)row * 768 + col0;
#pragma unroll
                for (int bj = 0; bj < 2; ++bj) {
                    const int g = 8 * u.pn + 4 * bj + wc;
                    f32x4 v0 = acc[ai][bj][m][0] * rs, v1 = acc[ai][bj][m][1] * rs;
                    if (g % 3 == 2) {
                        const f32x4* tp = (const f32x4*)(rope + ((size_t)pos * 16 + 8 * (fq & 1)) * 2);
                        const f32x4 t0 = tp[0], t1 = tp[1], t2 = tp[2], t3 = tp[3];
                        f32x4 p0, p1;
#pragma unroll
                        for (int j = 0; j < 4; ++j) {
                            auto r0 = __builtin_amdgcn_permlane32_swap(__float_as_uint(v0[j]), __float_as_uint(v0[j]), false, false); p0[j] = __uint_as_float(up ? r0[0] : r0[1]);
                            auto r1 = __builtin_amdgcn_permlane32_swap(__float_as_uint(v1[j]), __float_as_uint(v1[j]), false, false); p1[j] = __uint_as_float(up ? r1[0] : r1[1]); }
                        v0[0] = v0[0] * t0[0] + sg * p0[0] * t0[1]; v0[1] = v0[1] * t0[2] + sg * p0[1] * t0[3];
                        v0[2] = v0[2] * t1[0] + sg * p0[2] * t1[1]; v0[3] = v0[3] * t1[2] + sg * p0[3] * t1[3];
                        v1[0] = v1[0] * t2[0] + sg * p1[0] * t2[1]; v1[1] = v1[1] * t2[2] + sg * p1[1] * t2[3];
                        v1[2] = v1[2] * t3[0] + sg * p1[2] * t3[1]; v1[3] = v1[3] * t3[2] + sg * p1[3] * t3[3];
                    }
                    *(u32x4*)(rowp + bj * HALF) = pack8(v0, v1);
                }
                asm volatile("" ::: "memory");
            }
    }
};
struct EpiKV {
    static constexpr bool PERM = true, AFTER_DRAIN = false;
    bf16_t* KM; bf16_t* VM; const float* partkv; float eps;
    __device__ __forceinline__ void operator()(const f32x4 (&acc)[2][2][4][2], const Unit& u, int wr, int wc, int fr, int fq) const {
        const int row0 = u.pm * BM + wr * 64 + fr;
#pragma unroll
        for (int ai = 0; ai < 2; ++ai)
#pragma unroll
            for (int m = 0; m < 4; ++m) {
                const int row = row0 + ai * HALF + m * 16;
                const f32x4 pq = *(const f32x4*)(partkv + (size_t)row * 4);
                const float rs = __builtin_amdgcn_rsqf(((pq[0] + pq[1]) + (pq[2] + pq[3])) * (1.f / 128.f) + eps);
#pragma unroll
                for (int bj = 0; bj < 2; ++bj) {
                    const int c = u.pn * BM + bj * HALF + wc * 32 + 8 * fq;
                    bf16_t* dst = (u.pn < 2) ? KM + (size_t)row * 768 + (c >> 6) * 96 + (c & 63) : VM + (size_t)row * 512 + (c - 512);
                    *(u32x4*)dst = pack8(acc[ai][bj][m][0] * rs, acc[ai][bj][m][1] * rs);
                }
            }
    }
};

template <class Epi, class Sched, bool ALIGN_EPI = false>
__device__ __forceinline__ void gemm_phase(PG8_LAS unsigned char* lds, const Gemm g, const Sched& S, const Epi& E, const int wave  ) {
    int lane_; asm volatile("v_mbcnt_lo_u32_b32 %0, -1, 0\n\tv_mbcnt_hi_u32_b32 %0, -1, %0" : "=v"(lane_));
    const int wid = wave, lane = lane_, tid = wid * 64 + lane, wr = wid >> 2, wc = wid & 3, fr = lane & 15, fq = lane >> 4;
    const int K = g.K, nt = K / BK;
    unsigned voffA[2], voffB[2];
#pragma unroll
    for (int i = 0; i < 2; ++i) { int R, C; stage_rc(tid * 16 + i * 8192, R, C); const int Rb = Epi::PERM ? ((R & ~31) + perm32(R & 31)) : R;
        voffA[i] = (unsigned)(R * g.lda + C) * 2u; voffB[i] = (unsigned)(Rb * g.ldb + C) * 2u; }
    const size_t kstep = (size_t)(BK * 2);
    const size_t hstepA = (size_t)HALF * g.lda * 2, hstepB = (size_t)HALF * g.ldb * 2;
    const size_t tstepA = 2 * hstepA, tstepB = 2 * hstepB;
    const unsigned ldsw = (unsigned)wid * 1024u;
    const int aoff = lds_byte(wr * 64 + fr, fq * 8), boff = lds_byte(wc * 32 + fr, fq * 8);
#define PG8_SA(b, h) (((b) * 2 + (h)) * HTB)
#define PG8_SB(b, h) ((4 + (b) * 2 + (h)) * HTB)
#define PG8_STAGE(bufoff, gbase, voff) do { _Pragma("unroll") for (int _i = 0; _i < 2; ++_i) \
        __builtin_amdgcn_global_load_lds((const unsigned*)((const char*)(gbase) + (voff)[_i]), (PG8_LAS unsigned*)(lds + (bufoff) + ldsw + _i * 8192), 16, 0, 0); } while (0)
#define PG8_LDA(dst, b, h) do { _Pragma("unroll") for (int m = 0; m < 4; ++m) _Pragma("unroll") for (int k = 0; k < 2; ++k) dst[m][k] = *(const PG8_LAS bf16x8*)(lds + PG8_SA(b, h) + aoff + m * 2048 + k * 1024); } while (0)
#define PG8_LDB(dst, b, h) do { _Pragma("unroll") for (int n = 0; n < 2; ++n) _Pragma("unroll") for (int k = 0; k < 2; ++k) dst[n][k] = *(const PG8_LAS bf16x8*)(lds + PG8_SB(b, h) + boff + n * 2048 + k * 1024); } while (0)
#define PG8_MMA(ai, bj, At, Bt) do { __builtin_amdgcn_s_setprio(1); _Pragma("unroll") for (int m = 0; m < 4; ++m) _Pragma("unroll") for (int n = 0; n < 2; ++n) _Pragma("unroll") for (int k = 0; k < 2; ++k) \
        acc[ai][bj][m][n] = __builtin_amdgcn_mfma_f32_16x16x32_bf16(Bt[n][k], At[m][k], acc[ai][bj][m][n], 0, 0, 0); __builtin_amdgcn_s_setprio(0); } while (0)
#define PG8_WAIT_V(n) asm volatile("s_waitcnt vmcnt(" #n ")" ::: "memory")
#define PG8_WAIT_L(n) asm volatile("s_waitcnt lgkmcnt(" #n ")" ::: "memory")
#define PG8_BAR __builtin_amdgcn_s_barrier()
#define PG8_SCHED __builtin_amdgcn_sched_barrier(0)
    Unit cur, nxt; int ui = 0;
    if (!S.next(0, cur)) return;
    f32x4 acc[2][2][4][2];
#pragma unroll
    for (int a = 0; a < 2; ++a)
#pragma unroll
        for (int b = 0; b < 2; ++b)
#pragma unroll
            for (int m = 0; m < 4; ++m)
#pragma unroll
                for (int n = 0; n < 2; ++n) acc[a][b][m][n] = (f32x4){0.f, 0.f, 0.f, 0.f};
    bf16x8 At[4][2], B0[2][2], B1[2][2];
    const char* cA = (const char*)g.A + (size_t)cur.pm * tstepA; const char* cB = (const char*)g.Bt + (size_t)cur.pn * tstepB;
    PG8_STAGE(PG8_SB(0, 0), cB, voffB); PG8_STAGE(PG8_SB(0, 1), cB + hstepB, voffB); PG8_STAGE(PG8_SA(0, 0), cA, voffA); PG8_STAGE(PG8_SA(0, 1), cA + hstepA, voffA);
    if (wr == 1) PG8_BAR;
    PG8_WAIT_V(2); PG8_BAR;
    PG8_STAGE(PG8_SB(1, 0), cB + kstep, voffB); PG8_STAGE(PG8_SA(1, 0), cA + kstep, voffA); PG8_STAGE(PG8_SB(1, 1), cB + hstepB + kstep, voffB);
    PG8_WAIT_V(6); PG8_BAR;
    for (;;) {
        const bool has_next = S.next(ui + 1, nxt);
        const char* nA = has_next ? (const char*)g.A + (size_t)nxt.pm * tstepA : cA; const char* nB = has_next ? (const char*)g.Bt + (size_t)nxt.pn * tstepB : cB;
        for (int t = 0; t < nt; t += 2) {
            const bool last = (t == nt - 2);
            const char* a1 = cA + (size_t)(t + 1) * kstep;
            const char* a2 = last ? nA : cA + (size_t)(t + 2) * kstep; const char* b2 = last ? nB : cB + (size_t)(t + 2) * kstep;
            const char* a3 = a2 + kstep; const char* b3 = b2 + kstep;
            PG8_LDB(B0, 0, 0); PG8_LDB(B1, 0, 1); PG8_SCHED; PG8_LDA(At, 0, 0); PG8_STAGE(PG8_SA(1, 1), a1 + hstepA, voffA);
            PG8_WAIT_V(8); PG8_WAIT_L(0); PG8_BAR; PG8_MMA(0, 0, At, B0); PG8_MMA(0, 1, At, B1); PG8_BAR; PG8_SCHED;
            PG8_LDA(At, 0, 1); PG8_STAGE(PG8_SB(0, 0), b2, voffB); PG8_STAGE(PG8_SB(0, 1), b2 + hstepB, voffB); PG8_STAGE(PG8_SA(0, 0), a2, voffA);
            PG8_WAIT_V(8); PG8_WAIT_L(0); PG8_BAR; PG8_MMA(1, 0, At, B0); PG8_MMA(1, 1, At, B1); PG8_BAR; PG8_SCHED;
            PG8_LDB(B0, 1, 0); PG8_LDB(B1, 1, 1); PG8_SCHED; PG8_LDA(At, 1, 0); PG8_STAGE(PG8_SA(0, 1), a2 + hstepA, voffA);
            PG8_WAIT_V(8); PG8_WAIT_L(0); PG8_BAR; PG8_MMA(0, 0, At, B0); PG8_MMA(0, 1, At, B1); PG8_BAR; PG8_SCHED;
            PG8_LDA(At, 1, 1); PG8_STAGE(PG8_SB(1, 0), b3, voffB); PG8_STAGE(PG8_SB(1, 1), b3 + hstepB, voffB); PG8_STAGE(PG8_SA(1, 0), a3, voffA);
            PG8_WAIT_V(8); PG8_WAIT_L(0); PG8_BAR; PG8_MMA(1, 0, At, B0); PG8_MMA(1, 1, At, B1); PG8_BAR; PG8_SCHED;
        }
        if constexpr (ALIGN_EPI) { if (wr == 0) PG8_BAR; }
        if constexpr (!Epi::AFTER_DRAIN) { E(acc, cur, wr, wc, fr, fq); }
        if (!has_next) break;
#pragma unroll
        for (int a = 0; a < 2; ++a)
#pragma unroll
            for (int b = 0; b < 2; ++b)
#pragma unroll
                for (int m = 0; m < 4; ++m)
#pragma unroll
                    for (int n = 0; n < 2; ++n) acc[a][b][m][n] = (f32x4){0.f, 0.f, 0.f, 0.f};
        cur = nxt; cA = nA; cB = nB; ++ui;
        if constexpr (ALIGN_EPI) { if (wr == 1) PG8_BAR; }
    }
    PG8_WAIT_V(0);
    if constexpr (!ALIGN_EPI) { if (wr == 0) PG8_BAR; }
    PG8_BAR;
    if constexpr (Epi::AFTER_DRAIN) { E.fused(acc, cur, wr, wc, fr, fq, lds, wid, lane); }
#undef PG8_SA
#undef PG8_SB
#undef PG8_STAGE
#undef PG8_LDA
#undef PG8_LDB
#undef PG8_MMA
#undef PG8_WAIT_V
#undef PG8_WAIT_L
#undef PG8_BAR
#undef PG8_SCHED
}
}
namespace att {
#define ALAS __attribute__((address_space(3)))
typedef unsigned short bf16_t;
using bf16x8 = __attribute__((ext_vector_type(8))) short;
using s16x4 = __attribute__((ext_vector_type(4))) short;
using f32x16 = __attribute__((ext_vector_type(16))) float;
using f32x4 = __attribute__((ext_vector_type(4))) float;
using u32x4 = __attribute__((ext_vector_type(4))) unsigned;
typedef ALAS const char* lds_cptr;
typedef ALAS char* lds_ptr;
typedef short v4i16_t __attribute__((ext_vector_type(4)));
constexpr int SEQ = 4096;
constexpr float THR = 8.0f;
__device__ __forceinline__ int crow(int r, int hi) { return (r & 3) + 8 * (r >> 2) + 4 * hi; }
#define MFMA32(a, b, c) __builtin_amdgcn_mfma_f32_32x32x16_bf16(a, b, c, 0, 0, 0)
#define AWAIT_BAR(N) asm volatile("s_waitcnt vmcnt(" #N ") lgkmcnt(0)\n\ts_barrier" ::: "memory")
__device__ __forceinline__ void glds16(const void* gsrc, unsigned lds_dst) { unsigned keep;
    asm volatile("s_mov_b32 %0, m0\n\ts_mov_b32 m0, %2\n\ts_nop 0\n\tglobal_load_lds_dwordx4 %1, off\n\ts_mov_b32 m0, %0" : "=&s"(keep) : "v"(gsrc), "s"(lds_dst) : "memory"); }
typedef float f32x2_t __attribute__((ext_vector_type(2))); typedef __bf16 bf16x2_t __attribute__((ext_vector_type(2)));
__device__ __forceinline__ unsigned cvtpk(float lo, float hi) { f32x2_t v = {lo, hi}; bf16x2_t b = __builtin_convertvector(v, bf16x2_t); return __builtin_bit_cast(unsigned, b); }
__device__ __forceinline__ s16x4 vtr(lds_cptr p) { return __builtin_bit_cast(s16x4, __builtin_amdgcn_ds_read_tr16_b64_v4i16((ALAS v4i16_t*)p)); }

template <int ND0> __device__ __forceinline__ void qkt(f32x16& p0, f32x16& p1, lds_cptr kp, const bf16x8* qr, const f32x16& cinit) {
#pragma unroll
    for (int d0 = 0; d0 < ND0; ++d0) {
        const bf16x8 b0 = *(const ALAS bf16x8*)(kp + d0 * 2048);
        const bf16x8 b1 = *(const ALAS bf16x8*)(kp + d0 * 2048 + 512);
        if (d0 == 0) { p0 = MFMA32(b0, qr[0], cinit); p1 = MFMA32(b1, qr[0], cinit); }
        else { p0 = MFMA32(b0, qr[d0], p0); p1 = MFMA32(b1, qr[d0], p1); }
    }
}
__device__ __forceinline__ void pv(f32x16* o, lds_cptr vp, bf16x8 pa0, bf16x8 pa1, bf16x8 pa2, bf16x8 pa3) {
#pragma unroll
    for (int d0 = 0; d0 < 2; ++d0) {
        s16x4 lo[4], hi4[4];
#pragma unroll
        for (int ks = 0; ks < 4; ++ks) { lo[ks] = vtr(vp + d0 * 4096 + ks * 1024); hi4[ks] = vtr(vp + d0 * 4096 + ks * 1024 + 512); }
#define APK(k) (bf16x8){lo[k][0], lo[k][1], lo[k][2], lo[k][3], hi4[k][0], hi4[k][1], hi4[k][2], hi4[k][3]}
        o[d0] = MFMA32(pa0, APK(0), o[d0]);
        o[d0] = MFMA32(pa1, APK(1), o[d0]);
        o[d0] = MFMA32(pa2, APK(2), o[d0]);
        o[d0] = MFMA32(pa3, APK(3), o[d0]);
#undef APK
    }
}
struct SmState { float mhat, l; f32x16 o[2]; bool first; };
__device__ __forceinline__ void sm_pv(SmState& st, f32x16& p0, f32x16& p1, lds_cptr vp, ALAS float* wsf, int r32, int hi) {
    float a = fmaxf(fmaxf(p0[0], p0[1]), p1[0]), b = fmaxf(fmaxf(p0[2], p0[3]), p1[1]); a = fmaxf(fmaxf(a, p1[2]), p1[3]);
#pragma unroll
    for (int r = 4; r < 16; r += 4) { a = fmaxf(fmaxf(a, p0[r]), p0[r + 1]); b = fmaxf(fmaxf(b, p0[r + 2]), p0[r + 3]); a = fmaxf(fmaxf(a, p1[r]), p1[r + 1]); b = fmaxf(fmaxf(b, p1[r + 2]), p1[r + 3]); }
    float rm = fmaxf(a, b);
    { auto rr = __builtin_amdgcn_permlane32_swap(__float_as_uint(rm), __float_as_uint(rm), false, false); rm = fmaxf(__uint_as_float(rr[0]), __uint_as_float(rr[1])); }
    if (st.first) {
        st.mhat = rm;
#pragma unroll
        for (int r = 0; r < 16; ++r) { p0[r] -= rm; p1[r] -= rm; }
        st.first = false;
    } else if (__any(rm > THR)) {
        const float dl = fmaxf(rm, 0.f); st.mhat += dl;
#pragma unroll
        for (int r = 0; r < 16; ++r) { p0[r] -= dl; p1[r] -= dl; }
        const float f = __builtin_amdgcn_exp2f(-dl); st.l *= f;
        if (hi == 0) wsf[r32] = f;
        asm volatile("s_waitcnt lgkmcnt(0)" ::: "memory");
#pragma unroll
        for (int d_ = 0; d_ < 2; ++d_)
#pragma unroll
            for (int r = 0; r < 16; ++r) st.o[d_][r] *= wsf[crow(r, hi)];
    }
    float s = 0.f;
#pragma unroll
    for (int r = 0; r < 16; ++r) { p0[r] = __builtin_amdgcn_exp2f(p0[r]); p1[r] = __builtin_amdgcn_exp2f(p1[r]); s += p0[r] + p1[r]; }
    st.l += s;
    u32x4 w0 = {cvtpk(p0[0], p0[1]), cvtpk(p0[2], p0[3]), cvtpk(p0[4], p0[5]), cvtpk(p0[6], p0[7])};
    u32x4 w1 = {cvtpk(p0[8], p0[9]), cvtpk(p0[10], p0[11]), cvtpk(p0[12], p0[13]), cvtpk(p0[14], p0[15])};
    u32x4 w2 = {cvtpk(p1[0], p1[1]), cvtpk(p1[2], p1[3]), cvtpk(p1[4], p1[5]), cvtpk(p1[6], p1[7])};
    u32x4 w3 = {cvtpk(p1[8], p1[9]), cvtpk(p1[10], p1[11]), cvtpk(p1[12], p1[13]), cvtpk(p1[14], p1[15])};
    pv(st.o, vp, __builtin_bit_cast(bf16x8, w0), __builtin_bit_cast(bf16x8, w1), __builtin_bit_cast(bf16x8, w2), __builtin_bit_cast(bf16x8, w3));
}
__device__ __forceinline__ float finish_store(SmState& st, ALAS float* wsf, ALAS bf16_t* stg, bf16_t* orow0, size_t rstride, int lane, int r32, int hi) {
    float l = st.l;
    { auto rr = __builtin_amdgcn_permlane32_swap(__float_as_uint(l), __float_as_uint(l), false, false); l = __uint_as_float(rr[0]) + __uint_as_float(rr[1]); }
    if (hi == 0) wsf[32 + r32] = l;
    asm volatile("s_waitcnt lgkmcnt(0)" ::: "memory");
#pragma unroll
    for (int r = 0; r < 16; ++r) { const float rl = __builtin_amdgcn_rcpf(wsf[32 + crow(r, hi)]); const int orow = crow(r, hi);
#pragma unroll
        for (int d0 = 0; d0 < 2; ++d0) { const float v = st.o[d0][r] * rl; stg[orow * 64 + d0 * 32 + r32] = (bf16_t)(cvtpk(v, v) & 0xffffu); } }
    asm volatile("s_waitcnt lgkmcnt(0)" ::: "memory");
#pragma unroll
    for (int i = 0; i < 4; ++i) { const int row = i * 8 + (lane >> 3), ch = lane & 7; const u32x4 v = *(const ALAS u32x4*)(stg + row * 64 + ch * 8); *(u32x4*)(orow0 + (size_t)row * rstride + ch * 8) = v; }
    return st.mhat + __builtin_amdgcn_logf(l);
}

constexpr int MK_SLOT = 12288, MV_SLOT = 8192, M_LDS_K = 0, M_LDS_V = 3 * MK_SLOT, M_LDS_WS = M_LDS_V + 3 * MV_SLOT, M_LDS_OST = M_LDS_WS + 2048, M_LDS_BYTES = M_LDS_OST + 8 * 4096;
__device__ __forceinline__ void mla_unit(int b, int h, int qb, const bf16_t* QM, const bf16_t* KM, const bf16_t* VM, bf16_t* OA, lds_ptr shm, const int wave) {
    int lane_; asm volatile("v_mbcnt_lo_u32_b32 %0, -1, 0\n\tv_mbcnt_hi_u32_b32 %0, -1, %0" : "=v"(lane_));
    const int lane = lane_, r32 = lane & 31, hi = lane >> 5; const int wid = wave;
    const size_t rowb = (size_t)b * SEQ; const int q0 = qb * 256;
    const unsigned lds0 = (unsigned)(uintptr_t)shm;
    ALAS float* wsf = (ALAS float*)(shm + M_LDS_WS) + wid * 64;
    ALAS bf16_t* stg = (ALAS bf16_t*)(shm + M_LDS_OST) + wid * 2048;
    const bf16_t* ksrc = KM + (rowb + lane) * 768 + h * 96;
    const bf16_t* vsrc = VM + (rowb + 16 * (wid & 3) + (lane >> 2)) * 512 + h * 64 + (wid >> 2) * 32 + (lane & 3) * 8;
    const int NT = 4 * (qb + 1);
#define MDMA(t, sl) do { \
        glds16(ksrc + (size_t)(t) * 64 * 768 + wid * 8, (unsigned)__builtin_amdgcn_readfirstlane(lds0 + M_LDS_K + (sl) * MK_SLOT + wid * 1024)); \
        if (wid < 4) glds16(ksrc + (size_t)(t) * 64 * 768 + (8 + wid) * 8, (unsigned)__builtin_amdgcn_readfirstlane(lds0 + M_LDS_K + (sl) * MK_SLOT + (8 + wid) * 1024)); \
        glds16(vsrc + (size_t)(t) * 64 * 512, (unsigned)__builtin_amdgcn_readfirstlane(lds0 + M_LDS_V + (sl) * MV_SLOT + wid * 1024)); } while (0)
    bf16x8 qr[6];
    const bf16_t* qp = QM + (rowb + q0 + wid * 32 + r32) * 768 + h * 96 + hi * 8;
#pragma unroll
    for (int d0 = 0; d0 < 6; ++d0) qr[d0] = *(const bf16x8*)(qp + d0 * 16);
    MDMA(0, 0); MDMA(1, 1);
    SmState st; st.mhat = 0.f; st.l = 0.f; st.o[0] = f32x16{}; st.o[1] = f32x16{}; st.first = true;
    const int qw0 = q0 + wid * 32;
    const lds_cptr kp0 = (lds_cptr)shm + M_LDS_K + hi * 1024 + r32 * 16;
    const lds_cptr vp0 = (lds_cptr)shm + M_LDS_V + ((lane >> 4) & 1) * 32 + (lane & 3) * 8 + (4 * hi + ((lane & 15) >> 2)) * 64;
    int sl = 0;
    for (int t = 0; t < NT; ++t) {
        if (t + 1 < NT) { if (wid < 4) AWAIT_BAR(3); else AWAIT_BAR(2); } else AWAIT_BAR(0);
        if (t + 2 < NT) { const int s2 = (sl == 0) ? 2 : sl - 1; MDMA(t + 2, s2); }
        if (64 * t <= qw0 + 31) {
            f32x16 cinit;
#pragma unroll
            for (int r = 0; r < 16; ++r) cinit[r] = -st.mhat;
            f32x16 p0, p1;
            qkt<6>(p0, p1, kp0 + sl * MK_SLOT, qr, cinit);
            if (64 * t + 63 > qw0) {
                const int dq = qw0 + r32 - 64 * t;
#pragma unroll
                for (int r = 0; r < 16; ++r) { const int kv = crow(r, hi); if (kv > dq) p0[r] = -INFINITY; if (kv + 32 > dq) p1[r] = -INFINITY; }
            }
            sm_pv(st, p0, p1, vp0 + sl * MV_SLOT, wsf, r32, hi);
        }
        sl = (sl == 2) ? 0 : sl + 1;
    }
#undef MDMA
    (void)finish_store(st, wsf, stg, OA + (rowb + qw0) * 1024 + h * 64, 1024, lane, r32, hi);
    asm volatile("s_waitcnt lgkmcnt(0)\n\ts_barrier" ::: "memory");
}

constexpr int D_SLOT = 8192, D_LDS_K = 0, D_LDS_V = 6 * D_SLOT, D_LDS_WS = 12 * D_SLOT, D_LDS_OST = D_LDS_WS + 2048, D_LDS_BYTES = D_LDS_OST + 8 * 4096;
__device__ __forceinline__ void dil_subunit(int b, int h, int dil, int rc, int n, float cb  , const bf16_t* QD, const bf16_t* KD, const bf16_t* VD, bf16_t* DO, float* LSE, lds_ptr shm, const int wave) {
    int lane_; asm volatile("v_mbcnt_lo_u32_b32 %0, -1, 0\n\tv_mbcnt_hi_u32_b32 %0, -1, %0" : "=v"(lane_));
    const int lane = lane_, r32 = lane & 31, hi = lane >> 5; const int wid = wave;
    const size_t rowb = (size_t)b * SEQ;
    const unsigned lds0 = (unsigned)(uintptr_t)shm;
    ALAS float* wsf = (ALAS float*)(shm + D_LDS_WS) + wid * 64;
    ALAS bf16_t* stg = (ALAS bf16_t*)(shm + D_LDS_OST) + wid * 2048;
    const int tau0 = 4 * n - 2;
#pragma unroll
    for (int s = 0; s < 6; ++s) {
        const int tau = tau0 + s;
        if (tau >= 0) {
            const size_t tk = rowb + rc + (size_t)dil * (64 * tau + lane);
            glds16(KD + tk * 512 + h * 64 + wid * 8, (unsigned)__builtin_amdgcn_readfirstlane(lds0 + D_LDS_K + s * D_SLOT + wid * 1024));
            const size_t tv = rowb + rc + (size_t)dil * (64 * tau + 16 * (wid & 3) + (lane >> 2));
            glds16(VD + tv * 512 + h * 64 + (wid >> 2) * 32 + (lane & 3) * 8, (unsigned)__builtin_amdgcn_readfirstlane(lds0 + D_LDS_V + s * D_SLOT + wid * 1024));
        }
    }
    const int j0 = 256 * n + 32 * wid;
    bf16x8 qr[4];
    const bf16_t* qp = QD + (rowb + rc + (size_t)dil * (j0 + r32)) * 512 + h * 64 + hi * 8;
#pragma unroll
    for (int d0 = 0; d0 < 4; ++d0) qr[d0] = *(const bf16x8*)(qp + d0 * 16);
    SmState st; st.mhat = 0.f; st.l = 0.f; st.o[0] = f32x16{}; st.o[1] = f32x16{}; st.first = true;
    const lds_cptr kp0 = (lds_cptr)shm + D_LDS_K + hi * 1024 + r32 * 16;
    const lds_cptr vp0 = (lds_cptr)shm + D_LDS_V + ((lane >> 4) & 1) * 32 + (lane & 3) * 8 + (4 * hi + ((lane & 15) >> 2)) * 64;
    AWAIT_BAR(0);
#pragma unroll
    for (int k = 0; k < 3; ++k) {
        const int s = (wid >> 1) + k, tau = tau0 + s;
        if (tau >= 0) {
            const int dq = j0 + r32 - 64 * tau;
            const float ci = cb * (float)(4 * hi - dq) - st.mhat;
            f32x16 cinit;
#pragma unroll
            for (int r = 0; r < 16; ++r) cinit[r] = ci;
            f32x16 p0, p1;
            qkt<4>(p0, p1, kp0 + s * D_SLOT, qr, cinit);
#pragma unroll
            for (int r = 0; r < 16; ++r) { const float kc = (float)((r & 3) + 8 * (r >> 2)); p0[r] = fmaf(cb, kc, p0[r]); p1[r] = fmaf(cb, kc + 32.f, p1[r]); }
            if (k == 0) {
#pragma unroll
                for (int r = 0; r < 16; ++r) { const int kv = crow(r, hi); if (kv < dq - 128) p0[r] = -INFINITY; if (kv + 32 < dq - 128) p1[r] = -INFINITY; }
            }
            if (k == 2) {
#pragma unroll
                for (int r = 0; r < 16; ++r) { const int kv = crow(r, hi); if (kv > dq) p0[r] = -INFINITY; if (kv + 32 > dq) p1[r] = -INFINITY; }
            }
            sm_pv(st, p0, p1, vp0 + s * D_SLOT, wsf, r32, hi);
        }
    }
    const size_t orow = rowb + rc + (size_t)dil * j0;
    const float lse2 = finish_store(st, wsf, stg, DO + orow * 512 + h * 64, (size_t)dil * 512, lane, r32, hi);
    if (hi == 0) LSE[(orow + (size_t)dil * r32) * 8 + h] = lse2;
    asm volatile("s_waitcnt lgkmcnt(0)\n\ts_barrier" ::: "memory");
}
}
constexpr int NWAVES = 8;
#ifndef MK_SPLIT
#define MK_SPLIT 1
#endif
constexpr int NPHASE = 12;

constexpr int BATCH = 8, SEQ = 4096, DM = 1024, M = BATCH * SEQ, FF = 2816, NUP = 2 * FF;
constexpr float LN_EPS = 1e-5f, RMS_EPS = 1e-6f, DN_ALPHA = 1.189207115002721f;
constexpr float LOG2E = 1.4426950408889634f;
constexpr float C2M = 0.10206207261596577f * LOG2E;
constexpr float C2D = 0.125f * LOG2E;

constexpr size_t MiB = 1u << 20;
constexpr size_t WS_CTL = 0, CTL_ZERO_BYTES = 1 * MiB;
constexpr size_t WS_WIN = 2 * MiB, WS_WUQ = 6 * MiB, WS_WUKV = 7 * MiB, WS_WO = 8 * MiB, WS_WUP = 10 * MiB, WS_WDN = 21 * MiB, WS_ROPE = 27 * MiB;
constexpr size_t WS_PARTQ = 28 * MiB, WS_PARTKV = 29 * MiB, WS_LSE = 30 * MiB;
constexpr size_t WS_XB = 34 * MiB;
constexpr size_t WS_CQ = 98 * MiB;
constexpr size_t WS_CKV = 114 * MiB;
constexpr size_t WS_QD = 130 * MiB, WS_KD = 162 * MiB, WS_VD = 194 * MiB;
constexpr size_t WS_QM = 226 * MiB, WS_KM = 274 * MiB;
constexpr size_t WS_VM = 322 * MiB;
constexpr size_t WS_DO = 354 * MiB;
constexpr size_t WS_OA = 34 * MiB;
constexpr size_t WS_MIXF = 98 * MiB;
constexpr size_t WS_X1B = 226 * MiB;
constexpr size_t WS_U = 290 * MiB;
constexpr size_t WS_ACT = 34 * MiB;
constexpr size_t WS_FFNF = 290 * MiB;
constexpr size_t WS_END = 512 * MiB;
constexpr int CW_TMO = 0, CW_BAR = 4096;

constexpr int SCR_BYTES = 139264;
constexpr int LDSCTL_OFF = SCR_BYTES, MISC_OFF = LDSCTL_OFF + 320;
constexpr int LDS_BYTES = 147456;
static_assert(att::M_LDS_BYTES <= SCR_BYTES && att::D_LDS_BYTES <= SCR_BYTES && pg8::STAGE_BYTES <= SCR_BYTES && MISC_OFF + 128 <= LDS_BYTES, "LDS map");

#define GAS __attribute__((address_space(1)))
#define LAS __attribute__((address_space(3)))
typedef unsigned short bf16;
typedef unsigned v4u __attribute__((ext_vector_type(4)));
typedef unsigned v2u __attribute__((ext_vector_type(2)));
typedef float f32x4 __attribute__((ext_vector_type(4)));
typedef GAS unsigned gu32;
#define RLX_AGENT __ATOMIC_RELAXED, __HIP_MEMORY_SCOPE_AGENT
#define LDS_WAIT() asm volatile("s_waitcnt lgkmcnt(0)" ::: "memory")
#define VM_WAIT() asm volatile("s_waitcnt vmcnt(0)" ::: "memory")
__device__ __forceinline__ unsigned f2bf(float f) { unsigned u = __builtin_bit_cast(unsigned, f); return (u + 0x7fffu + ((u >> 16) & 1u)) >> 16; }
__device__ __forceinline__ unsigned pk2(float lo, float hi) { return f2bf(lo) | (f2bf(hi) << 16); }
__device__ __forceinline__ float bf2f(unsigned short b) { return __builtin_bit_cast(float, (unsigned)b << 16); }
__device__ __forceinline__ float bflo(unsigned w) { return __builtin_bit_cast(float, w << 16); }
__device__ __forceinline__ float bfhi(unsigned w) { return __builtin_bit_cast(float, w & 0xffff0000u); }

#define XB_TMO      128
#define XB_XCNT(j)  (256  + 64 * (j))
#define XB_XSUB(j)  (1280 + 64 * (j))
#define XB_XGEN(j)  (2304 + 64 * (j))
#define XB_TOP      3328
#define XB_TOPGEN   3392
#define XCD_BAR_WORDS 3456
#define XB_SPIN_CAP (1u << 18)
__device__ __forceinline__ unsigned xb_ld(unsigned* p)              { return __hip_atomic_load(p, __ATOMIC_RELAXED, __HIP_MEMORY_SCOPE_AGENT); }
__device__ __forceinline__ unsigned xb_add(unsigned* p, unsigned v) { return __hip_atomic_fetch_add(p, v, __ATOMIC_RELAXED, __HIP_MEMORY_SCOPE_AGENT); }
__device__ __forceinline__ unsigned xb_xcc_id() { return (unsigned)__builtin_amdgcn_s_getreg((3 << 11) | 20) & 0xFu; }
#define XB_SPIN(cond, bar) do { unsigned _sp = 0; while (cond) { __builtin_amdgcn_s_sleep(1); \
    if ((++_sp & 255u) == 0u) { if (xb_ld(&(bar)[XB_TMO])) break; if (_sp > XB_SPIN_CAP) { atomicAdd(&(bar)[XB_TMO], 1u); break; } } } } while (0)
struct XcdBarrier { unsigned* bar; unsigned x; volatile LAS unsigned* st; };
__device__ __forceinline__ XcdBarrier xcd_barrier_post(unsigned* bar, volatile LAS unsigned* st) {
    XcdBarrier b; b.bar = bar; b.x = xb_xcc_id(); b.st = st;
    if (threadIdx.x == 0) (void)xb_add(&bar[XB_XCNT(b.x)], 1u);
    return b;
}
__device__ __forceinline__ void xcd_barrier_complete(unsigned* bar, unsigned x, unsigned& nloc, unsigned& nx) {
    const unsigned G = gridDim.x * gridDim.y * gridDim.z;
    unsigned sum, cnt, mine, sp = 0u;
    for (;;) {
        sum = 0u; cnt = 0u; mine = 0u;
#pragma unroll
        for (unsigned j = 0; j < 16; ++j) { const unsigned c = xb_ld(&bar[XB_XCNT(j)]); sum += c; cnt += (c > 0u) ? 1u : 0u; mine = (j == x) ? c : mine; }
        if (sum == G) break;
        __builtin_amdgcn_s_sleep(1);
        if ((++sp & 255u) == 0u) { if (xb_ld(&bar[XB_TMO])) break; if (sp > XB_SPIN_CAP) { atomicAdd(&bar[XB_TMO], 1u); break; } }
    }
    nloc = mine > 0u ? mine : 1u; nx = cnt > 0u ? cnt : 1u;
}
__device__ __forceinline__ void xcd_barrier(const XcdBarrier& b) {
    asm volatile("s_waitcnt vmcnt(0)" ::: "memory");
    __syncthreads();
    if (threadIdx.x == 0) {
        unsigned* bar = b.bar;
        __builtin_amdgcn_s_waitcnt(0);
        unsigned nloc = b.st[0], nx = b.st[1];
        if (nloc == 0u) { xcd_barrier_complete(bar, b.x, nloc, nx); b.st[0] = nloc; b.st[1] = nx; }
        const unsigned old = xb_add(&bar[XB_XSUB(b.x)], 1u);
        const unsigned gen = old / nloc;
        if (old + 1u == (gen + 1u) * nloc) {
            __builtin_amdgcn_fence(__ATOMIC_RELEASE, "agent");
            asm volatile("s_waitcnt vmcnt(0)" ::: "memory");
            const unsigned og = xb_add(&bar[XB_TOP], 1u);
            const unsigned tg = og / nx;
            if (og + 1u == (tg + 1u) * nx) xb_add(&bar[XB_TOPGEN], 1u);
            else XB_SPIN(xb_ld(&bar[XB_TOPGEN]) == tg, bar);
            __builtin_amdgcn_fence(__ATOMIC_ACQUIRE, "agent");
            xb_add(&bar[XB_XGEN(b.x)], 1u);
            asm volatile("s_waitcnt vmcnt(0)" ::: "memory");
        } else {
            XB_SPIN(xb_ld(&bar[XB_XGEN(b.x)]) == gen, bar);
            __builtin_amdgcn_fence(__ATOMIC_ACQUIRE, "agent");
            asm volatile("s_waitcnt vmcnt(0)" ::: "memory");
        }
    }
    __syncthreads();
}

struct Frame {
    LAS unsigned char* lds;
    volatile LAS unsigned* MISC;
    gu32* ctl;
    int wave, vcu, G;
    const float *x, *w_in, *g_cq, *g_ckv, *w_uq, *w_uk, *w_uv, *w_o, *ln1_g, *ln1_b, *w_up, *conv_w, *conv_b, *w_down, *ln2_g, *ln2_b;
    float* out; unsigned char* ws;
};
__device__ __forceinline__ int hw_lane() { int l; asm volatile("v_mbcnt_lo_u32_b32 %0, -1, 0\n\tv_mbcnt_hi_u32_b32 %0, -1, %0" : "=v"(l)); return l; }
__device__ __forceinline__ float wave_sum(float v) {
#pragma unroll
    for (int o = 1; o < 64; o <<= 1) v += __shfl_xor(v, o);
    return v;
}
__device__ __forceinline__ void transpose_block(const float* W, int ldw, int k0, int c0, const float* ks, bf16* WT, int ldt, int r0, LAS float* scr, int lane) {
#pragma unroll 8
    for (int i = 0; i < 32; ++i) { const int kk = 2 * i + (lane >> 5); const float sc = ks ? ks[k0 + kk] : 1.f; scr[kk * 33 + (lane & 31)] = W[(size_t)(k0 + kk) * ldw + c0 + (lane & 31)] * sc; }
    LDS_WAIT(); asm volatile("" ::: "memory");
    const int c = lane & 7;
#pragma unroll
    for (int j = 0; j < 4; ++j) { const int n = (lane >> 3) + 8 * j; const LAS float* s = scr + (8 * c) * 33 + n;
        v4u o; o.x = pk2(s[0 * 33], s[1 * 33]); o.y = pk2(s[2 * 33], s[3 * 33]); o.z = pk2(s[4 * 33], s[5 * 33]); o.w = pk2(s[6 * 33], s[7 * 33]);
        *(GAS v4u*)(WT + (size_t)(r0 + n) * ldt + k0 + 8 * c) = o; }
    LDS_WAIT(); asm volatile("" ::: "memory");
}
__device__ __forceinline__ void p0_prologue(Frame& F) {
    const int lane = hw_lane();
    LAS float* scr = (LAS float*)(F.lds + F.wave * 16384);
    const int gw = F.vcu * NWAVES + F.wave, NGW = F.G * NWAVES;
    bf16* Win_t = (bf16*)(F.ws + WS_WIN); bf16* Wuq_t = (bf16*)(F.ws + WS_WUQ); bf16* Wukv_t = (bf16*)(F.ws + WS_WUKV); bf16* Wo_t = (bf16*)(F.ws + WS_WO);
    bf16* Wup_t = (bf16*)(F.ws + WS_WUP); bf16* Wdn_t = (bf16*)(F.ws + WS_WDN);
    constexpr int I_IN = 16 * 61, I_UQ = 4 * 24, I_UK = 2 * 16, I_UV = 2 * 16, I_O = 16 * 32, I_UP = 16 * 176, I_DN = 44 * 32;
    constexpr int NITEMS = I_IN + I_UQ + I_UK + I_UV + I_O + I_UP + I_DN;
    for (int it = gw; it < NITEMS; it += NGW) {
        int r = it;
        if (r < I_IN) { const int kb = r / 61, nb = r % 61, c0 = 32 * nb; transpose_block(F.w_in, 1952, 64 * kb, c0, nullptr, Win_t, 1024, c0 < 416 ? c0 : c0 + 96, scr, lane); continue; } r -= I_IN;
        if (r < I_UQ) { const int kb = r / 24, nb = r % 24; transpose_block(F.w_uq, 768, 64 * kb, 32 * nb, F.g_cq, Wuq_t, 256, 32 * nb, scr, lane); continue; } r -= I_UQ;
        if (r < I_UK) { const int kb = r / 16, nb = r % 16; transpose_block(F.w_uk, 512, 64 * kb, 32 * nb, F.g_ckv, Wukv_t, 128, 32 * nb, scr, lane); continue; } r -= I_UK;
        if (r < I_UV) { const int kb = r / 16, nb = r % 16; transpose_block(F.w_uv, 512, 64 * kb, 32 * nb, F.g_ckv, Wukv_t, 128, 512 + 32 * nb, scr, lane); continue; } r -= I_UV;
        if (r < I_O) { const int kb = r / 32, nb = r % 32; transpose_block(F.w_o, 1024, 64 * kb, 32 * nb, nullptr, Wo_t, 1024, 32 * nb, scr, lane); continue; } r -= I_O;
        if (r < I_UP) { const int kb = r / 176, nb = r % 176; const int nb2 = nb < 88 ? nb : nb - 88; const int r0 = 256 * (nb2 >> 2) + (nb < 88 ? 0 : 128) + (nb2 & 3) * 32;
            transpose_block(F.w_up, NUP, 64 * kb, 32 * nb, nullptr, Wup_t, 1024, r0, scr, lane); continue; } r -= I_UP;
        { const int kb = r / 32, nb = r % 32; transpose_block(F.w_down, 1024, 64 * kb, 32 * nb, nullptr, Wdn_t, FF, 32 * nb, scr, lane); }
    }
    { const int gt = gw * 64 + lane, NT = NGW * 64; for (int i = gt; i < 96 * 128; i += NT) *(GAS v4u*)(Win_t + (size_t)416 * 1024 + (size_t)i * 8) = (v4u){0u, 0u, 0u, 0u};
      float* rope = (float*)(F.ws + WS_ROPE);
      for (int i = gt; i < 4096 * 16; i += NT) { const int pos = i >> 4, k = i & 15; const float fr = powf(10000.0f, -(float)k / 16.0f); const float ang = (float)pos * fr; rope[2 * i] = cosf(ang); rope[2 * i + 1] = sinf(ang); } }
    bf16* XB = (bf16*)(F.ws + WS_XB);
    for (int m = gw; m < M; m += NGW) {
        const GAS f32x4* xr = (const GAS f32x4*)(F.x + (size_t)m * DM) + lane;
        GAS unsigned long long* o8 = (GAS unsigned long long*)(XB + (size_t)m * DM) + lane;
#pragma unroll
        for (int j = 0; j < 4; ++j) { const f32x4 v = xr[64 * j]; o8[64 * j] = (unsigned long long)pk2(v.x, v.y) | ((unsigned long long)pk2(v.z, v.w) << 32); }
    }
}
__device__ __forceinline__ void p2_krope(Frame& F) {
    const int lane = hw_lane();
    const bf16* CKV = (const bf16*)(F.ws + WS_CKV); bf16* KM = (bf16*)(F.ws + WS_KM); const float* rope = (const float*)(F.ws + WS_ROPE);
    const int gw = F.vcu * NWAVES + F.wave, NGW = F.G * NWAVES;
    const int rs = lane >> 5, h = (lane >> 2) & 7, q = lane & 3;
    for (int m2 = gw; m2 < M / 2; m2 += NGW) {
        const int m = 2 * m2 + rs, pos = m & 4095;
        const v4u a = *(const v4u*)(CKV + (size_t)m * 256 + 128 + 8 * (q & 1));
        const v4u b = *(const v4u*)(CKV + (size_t)m * 256 + 128 + 16 + 8 * (q & 1));
        const f32x4* tp = (const f32x4*)(rope + ((size_t)pos * 16 + 8 * (q & 1)) * 2);
        const f32x4 t0 = tp[0], t1 = tp[1], t2 = tp[2], t3 = tp[3];
        const float cs[8] = {t0[0], t0[2], t1[0], t1[2], t2[0], t2[2], t3[0], t3[2]}, sn[8] = {t0[1], t0[3], t1[1], t1[3], t2[1], t2[3], t3[1], t3[3]};
        const unsigned aw[4] = {a.x, a.y, a.z, a.w}, bw[4] = {b.x, b.y, b.z, b.w};
        float o[8];
#pragma unroll
        for (int j = 0; j < 4; ++j) {
            const float x1a = bflo(aw[j]), x1b = bfhi(aw[j]), x2a = bflo(bw[j]), x2b = bfhi(bw[j]);
            if (q < 2) { o[2 * j] = x1a * cs[2 * j] - x2a * sn[2 * j]; o[2 * j + 1] = x1b * cs[2 * j + 1] - x2b * sn[2 * j + 1]; }
            else { o[2 * j] = x1a * sn[2 * j] + x2a * cs[2 * j]; o[2 * j + 1] = x1b * sn[2 * j + 1] + x2b * cs[2 * j + 1]; }
        }
        v4u w; w.x = pk2(o[0], o[1]); w.y = pk2(o[2], o[3]); w.z = pk2(o[4], o[5]); w.w = pk2(o[6], o[7]);
        *(v4u*)(KM + (size_t)m * 768 + h * 96 + 64 + 8 * q) = w;
    }
}
__device__ __forceinline__ void p2_dilated(Frame& F) {
    const bf16* QD = (const bf16*)(F.ws + WS_QD); const bf16* KD = (const bf16*)(F.ws + WS_KD); const bf16* VD = (const bf16*)(F.ws + WS_VD);
    const int per = (3072 + F.G - 1) / F.G;
    for (int i = 0; i < per; ++i) {
        const int su = F.vcu * per + i; if (su >= 3072) break;
        const int bh = su / 48, k = su % 48, b = bh >> 3, h = bh & 7;
        int p, dil, rc, n;
        if (k < 16) { p = 0; dil = 1; rc = 0; n = k; } else if (k < 32) { p = 1; dil = 4; rc = (k - 16) >> 2; n = (k - 16) & 3; } else { p = 2; dil = 16; rc = k - 32; n = 0; }
        const float slope = __builtin_amdgcn_exp2f(-(float)(h + 1));
        att::dil_subunit(b, h, dil, rc, n, slope * (float)dil * LOG2E, QD, KD, VD, (bf16*)(F.ws + WS_DO) + (size_t)p * M * 512, (float*)(F.ws + WS_LSE) + (size_t)p * M * 8, (att::lds_ptr)F.lds, F.wave);
    }
}
__device__ __forceinline__ void p3_mla(Frame& F) {
    const bf16* QM = (const bf16*)(F.ws + WS_QM); const bf16* KM = (const bf16*)(F.ws + WS_KM); const bf16* VM = (const bf16*)(F.ws + WS_VM); bf16* OA = (bf16*)(F.ws + WS_OA);
    if (F.G == 256) {
        const int bh = F.vcu >> 2, s = F.vcu & 3;
        for (int i = 0; i < 4; ++i) { const int qb = (i == 0) ? 15 - s : (i == 1) ? 8 + s : (i == 2) ? 7 - s : s; att::mla_unit(bh >> 3, bh & 7, qb, QM, KM, VM, OA, (att::lds_ptr)F.lds, F.wave); }
    } else {
        for (int u = F.vcu; u < 1024; u += F.G) att::mla_unit(u >> 7, (u >> 4) & 7, u & 15, QM, KM, VM, OA, (att::lds_ptr)F.lds, F.wave);
    }
}
__device__ __forceinline__ void p3_combine(Frame& F) {
    const int lane = hw_lane();
    const bf16* DO = (const bf16*)(F.ws + WS_DO); const float* LSE = (const float*)(F.ws + WS_LSE); bf16* OA = (bf16*)(F.ws + WS_OA);
    const int gw = F.vcu * NWAVES + F.wave, NGW = F.G * NWAVES, h = lane >> 3;
    for (int m = gw; m < M; m += NGW) {
        const float l0 = LSE[(size_t)m * 8 + h], l1 = LSE[(size_t)M * 8 + (size_t)m * 8 + h], l2 = LSE[(size_t)2 * M * 8 + (size_t)m * 8 + h];
        const float mx = fmaxf(fmaxf(l0, l1), l2);
        float w0 = __builtin_amdgcn_exp2f(l0 - mx), w1 = __builtin_amdgcn_exp2f(l1 - mx), w2 = __builtin_amdgcn_exp2f(l2 - mx);
        const float inv = 1.0f / (w0 + w1 + w2); w0 *= inv; w1 *= inv; w2 *= inv;
        const v4u a = *(const v4u*)(DO + (size_t)m * 512 + lane * 8), b = *(const v4u*)(DO + (size_t)M * 512 + (size_t)m * 512 + lane * 8), c = *(const v4u*)(DO + (size_t)2 * M * 512 + (size_t)m * 512 + lane * 8);
        const unsigned aw[4] = {a.x, a.y, a.z, a.w}, bw[4] = {b.x, b.y, b.z, b.w}, cw[4] = {c.x, c.y, c.z, c.w};
        unsigned ow[4];
#pragma unroll
        for (int j = 0; j < 4; ++j) ow[j] = pk2(w0 * bflo(aw[j]) + w1 * bflo(bw[j]) + w2 * bflo(cw[j]), w0 * bfhi(aw[j]) + w1 * bfhi(bw[j]) + w2 * bfhi(cw[j]));
        *(v4u*)(OA + (size_t)m * 1024 + 512 + lane * 8) = (v4u){ow[0], ow[1], ow[2], ow[3]};
    }
}
__device__ __forceinline__ void ln_phase(Frame& F, const float* xin, const float* add, const float* g, const float* bb, float* outf, bf16* outb) {
    const int lane = hw_lane();
    const int gw = F.vcu * NWAVES + F.wave, NGW = F.G * NWAVES;
    for (int m = gw; m < M; m += NGW) {
        const f32x4* xr = (const f32x4*)(xin + (size_t)m * DM) + lane; const f32x4* ar = (const f32x4*)(add + (size_t)m * DM) + lane;
        f32x4 v[4]; float s = 0.f;
#pragma unroll
        for (int j = 0; j < 4; ++j) { v[j] = xr[64 * j] * DN_ALPHA + ar[64 * j]; s += (v[j].x + v[j].y) + (v[j].z + v[j].w); }
        const float mean = wave_sum(s) * (1.f / DM); float s2 = 0.f;
#pragma unroll
        for (int j = 0; j < 4; ++j) { v[j] = v[j] - mean; s2 += (v[j].x * v[j].x + v[j].y * v[j].y) + (v[j].z * v[j].z + v[j].w * v[j].w); }
        const float rstd = 1.f / sqrtf(wave_sum(s2) * (1.f / DM) + LN_EPS);
#pragma unroll
        for (int j = 0; j < 4; ++j) { const f32x4 gg = ((const f32x4*)g)[lane + 64 * j], be = ((const f32x4*)bb)[lane + 64 * j]; const f32x4 o = v[j] * rstd * gg + be;
            ((f32x4*)(outf + (size_t)m * DM))[lane + 64 * j] = o;
            if (outb) ((unsigned long long*)(outb + (size_t)m * DM))[lane + 64 * j] = (unsigned long long)pk2(o.x, o.y) | ((unsigned long long)pk2(o.z, o.w) << 32); }
    }
}
__device__ __forceinline__ float gelu_tanh(float x) { const float u = 0.7978845608028654f * (x + 0.044715f * x * x * x); const float e = __builtin_amdgcn_exp2f(2.0f * LOG2E * u); return x * (1.0f - 1.0f / (e + 1.0f)); }
__device__ __forceinline__ void conv_phase(Frame& F, int row0, int nrows) {
    const int lane = hw_lane();
    const bf16* U = (const bf16*)(F.ws + WS_U); bf16* ACT = (bf16*)(F.ws + WS_ACT);
    const size_t gt = (size_t)(F.vcu * NWAVES + F.wave) * 64 + lane, NT = (size_t)F.G * NWAVES * 64;
    for (size_t it = gt; it < (size_t)nrows * 352; it += NT) {
        const int lr = (int)(it / 352), cc = (int)(it % 352), ac = cc * 8;
        const int pn = ac >> 7, j0 = ac & 127, t = (row0 + lr) & 4095;
        float ya[8], yg[8];
#pragma unroll
        for (int e = 0; e < 8; ++e) { ya[e] = F.conv_b[ac + e]; yg[e] = F.conv_b[FF + ac + e]; }
#pragma unroll
        for (int tap = 0; tap < 3; ++tap) {
            const int sh = 2 - tap;
            if (t - sh >= 0) {
                const bf16* up = U + (size_t)(lr - sh) * NUP + pn * 256 + j0;
                const v4u a = *(const v4u*)up, g = *(const v4u*)(up + 128);
                const unsigned aw[4] = {a.x, a.y, a.z, a.w}, gw_[4] = {g.x, g.y, g.z, g.w};
#pragma unroll
                for (int e = 0; e < 4; ++e) {
                    ya[2 * e] = fmaf(F.conv_w[tap * NUP + ac + 2 * e], bflo(aw[e]), ya[2 * e]); ya[2 * e + 1] = fmaf(F.conv_w[tap * NUP + ac + 2 * e + 1], bfhi(aw[e]), ya[2 * e + 1]);
                    yg[2 * e] = fmaf(F.conv_w[tap * NUP + FF + ac + 2 * e], bflo(gw_[e]), yg[2 * e]); yg[2 * e + 1] = fmaf(F.conv_w[tap * NUP + FF + ac + 2 * e + 1], bfhi(gw_[e]), yg[2 * e + 1]);
                }
            }
        }
        v4u w; w.x = pk2(gelu_tanh(yg[0]) * ya[0], gelu_tanh(yg[1]) * ya[1]); w.y = pk2(gelu_tanh(yg[2]) * ya[2], gelu_tanh(yg[3]) * ya[3]);
        w.z = pk2(gelu_tanh(yg[4]) * ya[4], gelu_tanh(yg[5]) * ya[5]); w.w = pk2(gelu_tanh(yg[6]) * ya[6], gelu_tanh(yg[7]) * ya[7]);
        *(v4u*)(ACT + (size_t)(row0 + lr) * FF + ac) = w;
    }
}

struct Args { const float* in[16]; float* out; unsigned char* ws; int ph_lo, ph_hi; };
__global__ void __launch_bounds__(NWAVES * 64, 2) mk_fwd(Args args) {
    extern __shared__ __attribute__((aligned(16))) unsigned char lds[];
    Frame F;
    F.lds = (LAS unsigned char*)lds;
    F.MISC = (volatile LAS unsigned*)(F.lds + MISC_OFF);
    F.wave = __builtin_amdgcn_readfirstlane((int)threadIdx.x >> 6);
    F.G = gridDim.x; { const int bx = blockIdx.x; F.vcu = (F.G % 8 == 0) ? (bx % 8) * (F.G / 8) + bx / 8 : bx; }
    F.ws = args.ws; F.out = args.out; F.ctl = (gu32*)(args.ws + WS_CTL);
    F.x = args.in[0]; F.w_in = args.in[1]; F.g_cq = args.in[2]; F.g_ckv = args.in[3]; F.w_uq = args.in[4]; F.w_uk = args.in[5]; F.w_uv = args.in[6]; F.w_o = args.in[7];
    F.ln1_g = args.in[8]; F.ln1_b = args.in[9]; F.w_up = args.in[10]; F.conv_w = args.in[11]; F.conv_b = args.in[12]; F.w_down = args.in[13]; F.ln2_g = args.in[14]; F.ln2_b = args.in[15];
    for (int u = threadIdx.x; u < (LDS_BYTES - LDSCTL_OFF) / 4; u += NWAVES * 64) ((LAS unsigned*)(F.lds + LDSCTL_OFF))[u] = 0u;
    __syncthreads();
    XcdBarrier bar; bar.bar = (unsigned*)(F.ctl + CW_BAR); bar.x = 0; bar.st = nullptr;
    if (!MK_SPLIT) bar = xcd_barrier_post((unsigned*)(F.ctl + CW_BAR), F.MISC + 8);
    const int lo = args.ph_lo, hi = args.ph_hi;
#ifndef PHASE_MASK
#define PHASE_MASK 0xFFF
#endif
#define IN(k) (((PHASE_MASK >> (k)) & 1) && lo <= (k) && (k) < hi)
#define SEAM(k) do { if (IN(k) && IN((k) + 1)) xcd_barrier(bar); } while (0)
    bf16* Win_t = (bf16*)(F.ws + WS_WIN); bf16* Wuq_t = (bf16*)(F.ws + WS_WUQ); bf16* Wukv_t = (bf16*)(F.ws + WS_WUKV); bf16* Wo_t = (bf16*)(F.ws + WS_WO);
    bf16* Wup_t = (bf16*)(F.ws + WS_WUP); bf16* Wdn_t = (bf16*)(F.ws + WS_WDN);
    if (IN(0)) { p0_prologue(F); } SEAM(0);
    if (IN(1)) {
        pg8::Gemm g{(const bf16*)(F.ws + WS_XB), Win_t, M, 2048, DM, DM, DM}; pg8::StaticOrder S; S.init(M, 2048, F.G, (int)blockIdx.x);
        pg8::EpiH E{(bf16*)(F.ws + WS_CQ), (bf16*)(F.ws + WS_CKV), (bf16*)(F.ws + WS_QD), (bf16*)(F.ws + WS_KD), (bf16*)(F.ws + WS_VD), (float*)(F.ws + WS_PARTQ), (float*)(F.ws + WS_PARTKV), C2D};
        pg8::gemm_phase<pg8::EpiH, pg8::StaticOrder, true>(F.lds, g, S, E, F.wave);
    } SEAM(1);
    if (IN(2)) {
#ifndef P2SUB
#define P2SUB 15
#endif
        if (P2SUB & 1) { pg8::Gemm g{(const bf16*)(F.ws + WS_CQ), Wuq_t, M, 768, 256, 256, 256}; pg8::StaticOrder S; S.init(M, 768, F.G, (int)blockIdx.x);
          pg8::EpiQ E{(bf16*)(F.ws + WS_QM), (const float*)(F.ws + WS_PARTQ), (const float*)(F.ws + WS_ROPE), C2M, RMS_EPS};
          pg8::gemm_phase<pg8::EpiQ, pg8::StaticOrder, true>(F.lds, g, S, E, F.wave); }
        if (P2SUB & 2) { pg8::Gemm g{(const bf16*)(F.ws + WS_CKV), Wukv_t, M, 1024, 128, 256, 128}; pg8::StaticOrder S; S.init(M, 1024, F.G, (int)blockIdx.x);
          pg8::EpiKV E{(bf16*)(F.ws + WS_KM), (bf16*)(F.ws + WS_VM), (const float*)(F.ws + WS_PARTKV), RMS_EPS};
          pg8::gemm_phase<pg8::EpiKV, pg8::StaticOrder, true>(F.lds, g, S, E, F.wave); }
        if (P2SUB & 4) p2_krope(F);
        if (P2SUB & 8) p2_dilated(F);
    } SEAM(2);
    if (IN(3)) { p3_mla(F); p3_combine(F); } SEAM(3);
    if (IN(4)) {
        pg8::Gemm g{(const bf16*)(F.ws + WS_OA), Wo_t, M, DM, DM, DM, DM}; pg8::StaticOrder S; S.init(M, DM, F.G, (int)blockIdx.x);
        pg8::EpiStoreF32 E{(float*)(F.ws + WS_MIXF), DM};
        pg8::gemm_phase<pg8::EpiStoreF32, pg8::StaticOrder, true>(F.lds, g, S, E, F.wave);
    } SEAM(4);
    if (IN(5)) { ln_phase(F, F.x, (const float*)(F.ws + WS_MIXF), F.ln1_g, F.ln1_b, F.out, (bf16*)(F.ws + WS_X1B)); } SEAM(5);
    for (int hf = 0; hf < 2; ++hf) {
        if (IN(6 + 2 * hf)) {
            pg8::Gemm g{(const bf16*)(F.ws + WS_X1B) + (size_t)hf * (M / 2) * DM, Wup_t, M / 2, NUP, DM, DM, DM}; pg8::StaticOrder S; S.init(M / 2, NUP, F.G, (int)blockIdx.x);
            pg8::EpiStoreBf16 E{(bf16*)(F.ws + WS_U), NUP};
            pg8::gemm_phase<pg8::EpiStoreBf16, pg8::StaticOrder, true>(F.lds, g, S, E, F.wave);
        } SEAM(6 + 2 * hf);
        if (IN(7 + 2 * hf)) { conv_phase(F, hf * (M / 2), M / 2); } SEAM(7 + 2 * hf);
    }
    if (IN(10)) {
        pg8::Gemm g{(const bf16*)(F.ws + WS_ACT), Wdn_t, M, DM, FF, FF, FF}; pg8::StaticOrder S; S.init(M, DM, F.G, (int)blockIdx.x);
        pg8::EpiStoreF32 E{(float*)(F.ws + WS_FFNF), DM};
        pg8::gemm_phase<pg8::EpiStoreF32, pg8::StaticOrder, true>(F.lds, g, S, E, F.wave);
    } SEAM(10);
    if (IN(11)) { ln_phase(F, F.out, (const float*)(F.ws + WS_FFNF), F.ln2_g, F.ln2_b, F.out, nullptr); }
#undef IN
#undef SEAM
}

extern "C" void kernel_launch(void* const* d_in, const int* in_sizes, int n_in, void* d_out, int out_size, void* d_ws, size_t ws_size, hipStream_t stream) {
    static int grid = 0;
    if (grid == 0) {
        if (n_in != 16 || in_sizes[0] != M * DM || out_size != M * DM || ws_size < WS_END) { fprintf(stderr, "kernel_launch: unexpected shapes (n_in %d, ws %zu); nothing launched\n", n_in, ws_size); grid = -1; return; }
        int dev = 0, cus = 0;
        if (hipGetDevice(&dev) != hipSuccess || hipDeviceGetAttribute(&cus, hipDeviceAttributeMultiprocessorCount, dev) != hipSuccess) { grid = -1; return; }
        if (hipFuncSetAttribute((const void*)mk_fwd, hipFuncAttributeMaxDynamicSharedMemorySize, LDS_BYTES) != hipSuccess) { fprintf(stderr, "kernel_launch: hipFuncSetAttribute failed\n"); grid = -1; return; }
        (void)hipGetLastError();
        grid = cus;
    }
    if (grid < 0) return;
    if (hipMemsetAsync((char*)d_ws + WS_CTL, 0, CTL_ZERO_BYTES, stream) != hipSuccess) return;
    Args a{};
    for (int i = 0; i < 16; ++i) a.in[i] = (const float*)d_in[i];
    a.out = (float*)d_out; a.ws = (unsigned char*)d_ws;
    const int nl = MK_SPLIT ? NPHASE : 1;
    for (int li = 0; li < nl; ++li) {
        a.ph_lo = MK_SPLIT ? li : 0; a.ph_hi = MK_SPLIT ? li + 1 : NPHASE;
        hipLaunchKernelGGL(mk_fwd, dim3(grid), dim3(NWAVES * 64), LDS_BYTES, stream, a);
        if (hipPeekAtLastError() != hipSuccess) { fprintf(stderr, "kernel_launch: launch %d failed\n", li); break; }
    }
}
```

```cpp
#include <hip/hip_runtime.h>
#include <hip/hip_bf16.h>
#include <cstdio>
#include <cstdint>
#include <cmath>
namespace pg8 {
#define PG8_LAS __attribute__((address_space(3)))
typedef unsigned short bf16_t;
typedef short bf16x8 __attribute__((ext_vector_type(8)));
typedef float f32x4 __attribute__((ext_vector_type(4)));
typedef float f32x2 __attribute__((ext_vector_type(2)));
typedef unsigned u32x4 __attribute__((ext_vector_type(4)));
typedef unsigned u32x2 __attribute__((ext_vector_type(2)));
constexpr int BM = 256, BK = 64, HALF = 128, HTB = HALF * BK * 2  , STAGE_BYTES = 8 * HTB, NXCD = 8, WGM = 8;

__host__ __device__ __forceinline__ int lds_byte(int r, int c) { const int st = (r >> 4) * 2 + (c >> 5), rr = r & 15, cc = c & 31, ob = rr * 64 + cc * 2; return st * 1024 + (ob ^ (((ob >> 9) & 1) << 5)); }
__host__ __device__ __forceinline__ void stage_rc(int b, int& R, int& C) { const int st = b / 1024, sb = b % 1024, swz = sb ^ (((sb >> 9) & 1) << 5); R = (st >> 1) * 16 + swz / 64; C = (st & 1) * 32 + (swz % 64) / 2; }
__host__ __device__ __forceinline__ int perm32(int rho) { const int n = rho >> 4, i = rho & 15; return 8 * (i >> 2) + 4 * n + (i & 3); }

struct Unit { int pm, pn; };
struct Gemm { const bf16_t* A; const bf16_t* Bt; int M, N, K, lda, ldb; };

struct StaticOrder {
    int nM, nN, nwg, G, c;
    __host__ __device__ void init(int M, int N, int G_, int c_) { nM = M / BM; nN = N / BM; nwg = nM * nN; G = G_; c = c_; }
    __host__ __device__ bool next(int i, Unit& u) const {
        const long L = (long)i * G + c; if (L >= nwg) return false;
        int wgid = (int)L; { const int q = nwg / NXCD, r = nwg % NXCD, xcd = wgid % NXCD, off = wgid / NXCD; wgid = (xcd < r ? xcd * (q + 1) : r * (q + 1) + (xcd - r) * q) + off; }
        const int nig = WGM * nN, gid = wgid / nig, fm = gid * WGM, gsz = (nM - fm) < WGM ? (nM - fm) : WGM;
        u.pm = fm + ((wgid % nig) % gsz); u.pn = (wgid % nig) / gsz; return true;
    }
};

__device__ __forceinline__ unsigned cvt_pk_bf16(float lo, float hi) { unsigned r; asm volatile("v_cvt_pk_bf16_f32 %0, %1, %2" : "=v"(r) : "v"(lo), "v"(hi)); return r; }
__device__ __forceinline__ u32x4 pack8(const f32x4 v0, const f32x4 v1) { u32x4 w; w.x = cvt_pk_bf16(v0[0], v0[1]); w.y = cvt_pk_bf16(v0[2], v0[3]); w.z = cvt_pk_bf16(v1[0], v1[1]); w.w = cvt_pk_bf16(v1[2], v1[3]); return w; }


struct EpiStoreBf16 {
    static constexpr bool PERM = true, AFTER_DRAIN = false;
    bf16_t* O; int ldc;
    __device__ __forceinline__ void operator()(const f32x4 (&acc)[2][2][4][2], const Unit& u, int wr, int wc, int fr, int fq) const {
        const int row0 = u.pm * BM + wr * 64 + fr, col0 = u.pn * BM + wc * 32 + 8 * fq;
#pragma unroll
        for (int ai = 0; ai < 2; ++ai)
#pragma unroll
            for (int m = 0; m < 4; ++m) { bf16_t* rowp = O + (size_t)(row0 + ai * HALF + m * 16) * ldc + col0;
#pragma unroll
                for (int bj = 0; bj < 2; ++bj) *(u32x4*)(rowp + bj * HALF) = pack8(acc[ai][bj][m][0], acc[ai][bj][m][1]); }
    }
};
struct EpiStoreF32 {
    static constexpr bool PERM = false, AFTER_DRAIN = false;
    float* O; int ldc;
    __device__ __forceinline__ void operator()(const f32x4 (&acc)[2][2][4][2], const Unit& u, int wr, int wc, int fr, int fq) const {
        const int row0 = u.pm * BM + wr * 64 + fr, col0 = u.pn * BM + wc * 32 + 4 * fq;
#pragma unroll
        for (int ai = 0; ai < 2; ++ai)
#pragma unroll
            for (int m = 0; m < 4; ++m) { float* rowp = O + (size_t)(row0 + ai * HALF + m * 16) * ldc + col0;
#pragma unroll
                for (int bj = 0; bj < 2; ++bj)
#pragma unroll
                    for (int n = 0; n < 2; ++n) *(f32x4*)(rowp + bj * HALF + n * 16) = acc[ai][bj][m][n]; }
    }
};
struct EpiH {
    static constexpr bool PERM = true, AFTER_DRAIN = false;
    bf16_t *CQ, *CKV, *QD, *KD, *VD; float *partq, *partkv; float qscale;
    __device__ __forceinline__ void operator()(const f32x4 (&acc)[2][2][4][2], const Unit& u, int wr, int wc, int fr, int fq) const {
        const int pn = u.pn;
        bf16_t* base; int ldc, colt; float sc = 1.f;
        if (pn == 0) { base = CQ; ldc = 256; colt = 0; }
        else if (pn == 1) { base = CKV; ldc = 256; colt = 0; }
        else if (pn < 4) { base = QD; ldc = 512; colt = (pn - 2) * 256; sc = qscale; }
        else if (pn < 6) { base = KD; ldc = 512; colt = (pn - 4) * 256; }
        else { base = VD; ldc = 512; colt = (pn - 6) * 256; }
        const int row0 = u.pm * BM + wr * 64 + fr, col0 = colt + wc * 32 + 8 * fq;
#pragma unroll
        for (int ai = 0; ai < 2; ++ai)
#pragma unroll
            for (int m = 0; m < 4; ++m) { bf16_t* rowp = base + (size_t)(row0 + ai * HALF + m * 16) * ldc + col0;
#pragma unroll
                for (int bj = 0; bj < 2; ++bj) *(u32x4*)(rowp + bj * HALF) = pack8(acc[ai][bj][m][0] * sc, acc[ai][bj][m][1] * sc); }
        if (pn <= 1) {
            float* part = pn == 0 ? partq : partkv;
#pragma unroll
            for (int ai = 0; ai < 2; ++ai)
#pragma unroll
                for (int m = 0; m < 4; ++m) {
                    float s = 0.f;
#pragma unroll
                    for (int n = 0; n < 2; ++n) { const f32x4 x = acc[ai][0][m][n]; s += (x[0] * x[0] + x[1] * x[1]) + (x[2] * x[2] + x[3] * x[3]); }
                    if (pn == 0) {
#pragma unroll
                        for (int n = 0; n < 2; ++n) { const f32x4 x = acc[ai][1][m][n]; s += (x[0] * x[0] + x[1] * x[1]) + (x[2] * x[2] + x[3] * x[3]); }
                    }
                    s += __shfl_xor(s, 16); s += __shfl_xor(s, 32);
                    if (fq == 0) part[(size_t)(row0 + ai * HALF + m * 16) * 4 + wc] = s;
                }
        }
    }
};
struct EpiQ {
    static constexpr bool PERM = true, AFTER_DRAIN = false;
    bf16_t* QM; const float* partq; const float* rope; float c2m; float eps;
    __device__ __forceinline__ void operator()(const f32x4 (&acc)[2][2][4][2], const Unit& u, int wr, int wc, int fr, int fq) const {
        const int row0 = u.pm * BM + wr * 64 + fr, col0 = u.pn * BM + wc * 32 + 8 * fq;
        const bool up = fq >= 2;
        const float sg = up ? 1.f : -1.f;
#pragma unroll
        for (int ai = 0; ai < 2; ++ai)
#pragma unroll
            for (int m = 0; m < 4; ++m) {
                const int row = row0 + ai * HALF + m * 16;
                const f32x4 pq = *(const f32x4*)(partq + (size_t)row * 4);
                const float rs = c2m * __builtin_amdgcn_rsqf(((pq[0] + pq[1]) + (pq[2] + pq[3])) * (1.f / 256.f) + eps);
                const int pos = row & 4095;
                bf16_t* rowp = QM + (size_t)row * 768 + col0;
#pragma unroll
                for (int bj = 0; bj < 2; ++bj) {
                    const int g = 8 * u.pn + 4 * bj + wc;
                    f32x4 v0 = acc[ai][bj][m][0] * rs, v1 = acc[ai][bj][m][1] * rs;
                    if (g % 3 == 2) {
                        const f32x4* tp = (const f32x4*)(rope + ((size_t)pos * 16 + 8 * (fq & 1)) * 2);
                        const f32x4 t0 = tp[0], t1 = tp[1], t2 = tp[2], t3 = tp[3];
                        f32x4 p0, p1;
#pragma unroll
                        for (int j = 0; j < 4; ++j) {
                            auto r0 = __builtin_amdgcn_permlane32_swap(__float_as_uint(v0[j]), __float_as_uint(v0[j]), false, false); p0[j] = __uint_as_float(up ? r0[0] : r0[1]);
                            auto r1 = __builtin_amdgcn_permlane32_swap(__float_as_uint(v1[j]), __float_as_uint(v1[j]), false, false); p1[j] = __uint_as_float(up ? r1[0] : r1[1]); }
                        v0[0] = v0[0] * t0[0] + sg * p0[0] * t0[1]; v0[1] = v0[1] * t0[2] + sg * p0[1] * t0[3];
                        v0[2] = v0[2] * t1[0] + sg * p0[2] * t1[1]; v0[3] = v0[3] * t1[2] + sg * p0[3] * t1[3];
                        v1[0] = v1[0] * t2[0] + sg * p1[0] * t2[1]; v1[1] = v1[1] * t2[2] + sg * p1[1] * t2[3];
                        v1[2] = v1[2] * t3[0] + sg * p1[2] * t3[1]; v1[3] = v1[3] * t3[2] + sg * p1[3] * t3[3];
                    }
                    *(u32x4*)(rowp + bj * HALF) = pack8(v0, v1);
                }
                asm volatile("" ::: "memory");
            }
    }
};
struct EpiKV {
    static constexpr bool PERM = true, AFTER_DRAIN = false;
    bf16_t* KM; bf16_t* VM; const float* partkv; float eps;
    __device__ __forceinline__ void operator()(const f32x4 (&acc)[2][2][4][2], const Unit& u, int wr, int wc, int fr, int fq) const {
        const int row0 = u.pm * BM + wr * 64 + fr;
#pragma unroll
        for (int ai = 0; ai < 2; ++ai)
#pragma unroll
            for (int m = 0; m < 4; ++m) {
                const int row = row0 + ai * HALF + m * 16;
                const f32x4 pq = *(const f32x4*)(partkv + (size_t)row * 4);
                const float rs = __builtin_amdgcn_rsqf(((pq[0] + pq[1]) + (pq[2] + pq[3])) * (1.f / 128.f) + eps);
#pragma unroll
                for (int bj = 0; bj < 2; ++bj) {
                    const int c = u.pn * BM + bj * HALF + wc * 32 + 8 * fq;
                    bf16_t* dst = (u.pn < 2) ? KM + (size_t)row * 768 + (c >> 6) * 96 + (c & 63) : VM + (size_t)row * 512 + (c - 512);
                    *(u32x4*)dst = pack8(acc[ai][bj][m][0] * rs, acc[ai][bj][m][1] * rs);
                }
            }
    }
};

template <class Epi, class Sched, bool ALIGN_EPI = false>
__device__ __forceinline__ void gemm_phase(PG8_LAS unsigned char* lds, const Gemm g, const Sched& S, const Epi& E, const int wave  ) {
    int lane_; asm volatile("v_mbcnt_lo_u32_b32 %0, -1, 0\n\tv_mbcnt_hi_u32_b32 %0, -1, %0" : "=v"(lane_));
    const int wid = wave, lane = lane_, tid = wid * 64 + lane, wr = wid >> 2, wc = wid & 3, fr = lane & 15, fq = lane >> 4;
    const int K = g.K, nt = K / BK;
    unsigned voffA[2], voffB[2];
#pragma unroll
    for (int i = 0; i < 2; ++i) { int R, C; stage_rc(tid * 16 + i * 8192, R, C); const int Rb = Epi::PERM ? ((R & ~31) + perm32(R & 31)) : R;
        voffA[i] = (unsigned)(R * g.lda + C) * 2u; voffB[i] = (unsigned)(Rb * g.ldb + C) * 2u; }
    const size_t kstep = (size_t)(BK * 2);
    const size_t hstepA = (size_t)HALF * g.lda * 2, hstepB = (size_t)HALF * g.ldb * 2;
    const size_t tstepA = 2 * hstepA, tstepB = 2 * hstepB;
    const unsigned ldsw = (unsigned)wid * 1024u;
    const int aoff = lds_byte(wr * 64 + fr, fq * 8), boff = lds_byte(wc * 32 + fr, fq * 8);
#define PG8_SA(b, h) (((b) * 2 + (h)) * HTB)
#define PG8_SB(b, h) ((4 + (b) * 2 + (h)) * HTB)
#define PG8_STAGE(bufoff, gbase, voff) do { _Pragma("unroll") for (int _i = 0; _i < 2; ++_i) \
        __builtin_amdgcn_global_load_lds((const unsigned*)((const char*)(gbase) + (voff)[_i]), (PG8_LAS unsigned*)(lds + (bufoff) + ldsw + _i * 8192), 16, 0, 0); } while (0)
#define PG8_LDA(dst, b, h) do { _Pragma("unroll") for (int m = 0; m < 4; ++m) _Pragma("unroll") for (int k = 0; k < 2; ++k) dst[m][k] = *(const PG8_LAS bf16x8*)(lds + PG8_SA(b, h) + aoff + m * 2048 + k * 1024); } while (0)
#define PG8_LDB(dst, b, h) do { _Pragma("unroll") for (int n = 0; n < 2; ++n) _Pragma("unroll") for (int k = 0; k < 2; ++k) dst[n][k] = *(const PG8_LAS bf16x8*)(lds + PG8_SB(b, h) + boff + n * 2048 + k * 1024); } while (0)
#define PG8_MMA(ai, bj, At, Bt) do { __builtin_amdgcn_s_setprio(1); _Pragma("unroll") for (int m = 0; m < 4; ++m) _Pragma("unroll") for (int n = 0; n < 2; ++n) _Pragma("unroll") for (int k = 0; k < 2; ++k) \
        acc[ai][bj][m][n] = __builtin_amdgcn_mfma_f32_16x16x32_bf16(Bt[n][k], At[m][k], acc[ai][bj][m][n], 0, 0, 0); __builtin_amdgcn_s_setprio(0); } while (0)
#define PG8_WAIT_V(n) asm volatile("s_waitcnt vmcnt(" #n ")" ::: "memory")
#define PG8_WAIT_L(n) asm volatile("s_waitcnt lgkmcnt(" #n ")" ::: "memory")
#define PG8_BAR __builtin_amdgcn_s_barrier()
#define PG8_SCHED __builtin_amdgcn_sched_barrier(0)
    Unit cur, nxt; int ui = 0;
    if (!S.next(0, cur)) return;
    f32x4 acc[2][2][4][2];
#pragma unroll
    for (int a = 0; a < 2; ++a)
#pragma unroll
        for (int b = 0; b < 2; ++b)
#pragma unroll
            for (int m = 0; m < 4; ++m)
#pragma unroll
                for (int n = 0; n < 2; ++n) acc[a][b][m][n] = (f32x4){0.f, 0.f, 0.f, 0.f};
    bf16x8 At[4][2], B0[2][2], B1[2][2];
    const char* cA = (const char*)g.A + (size_t)cur.pm * tstepA; const char* cB = (const char*)g.Bt + (size_t)cur.pn * tstepB;
    PG8_STAGE(PG8_SB(0, 0), cB, voffB); PG8_STAGE(PG8_SB(0, 1), cB + hstepB, voffB); PG8_STAGE(PG8_SA(0, 0), cA, voffA); PG8_STAGE(PG8_SA(0, 1), cA + hstepA, voffA);
    if (wr == 1) PG8_BAR;
    PG8_WAIT_V(2); PG8_BAR;
    PG8_STAGE(PG8_SB(1, 0), cB + kstep, voffB); PG8_STAGE(PG8_SA(1, 0), cA + kstep, voffA); PG8_STAGE(PG8_SB(1, 1), cB + hstepB + kstep, voffB);
    PG8_WAIT_V(6); PG8_BAR;
    for (;;) {
        const bool has_next = S.next(ui + 1, nxt);
        const char* nA = has_next ? (const char*)g.A + (size_t)nxt.pm * tstepA : cA; const char* nB = has_next ? (const char*)g.Bt + (size_t)nxt.pn * tstepB : cB;
        for (int t = 0; t < nt; t += 2) {
            const bool last = (t == nt - 2);
            const char* a1 = cA + (size_t)(t + 1) * kstep;
            const char* a2 = last ? nA : cA + (size_t)(t + 2) * kstep; const char* b2 = last ? nB : cB + (size_t)(t + 2) * kstep;
            const char* a3 = a2 + kstep; const char* b3 = b2 + kstep;
            PG8_LDB(B0, 0, 0); PG8_LDB(B1, 0, 1); PG8_SCHED; PG8_LDA(At, 0, 0); PG8_STAGE(PG8_SA(1, 1), a1 + hstepA, voffA);
            PG8_WAIT_V(8); PG8_WAIT_L(0); PG8_BAR; PG8_MMA(0, 0, At, B0); PG8_MMA(0, 1, At, B1); PG8_BAR; PG8_SCHED;
            PG8_LDA(At, 0, 1); PG8_STAGE(PG8_SB(0, 0), b2, voffB); PG8_STAGE(PG8_SB(0, 1), b2 + hstepB, voffB); PG8_STAGE(PG8_SA(0, 0), a2, voffA);
            PG8_WAIT_V(8); PG8_WAIT_L(0); PG8_BAR; PG8_MMA(1, 0, At, B0); PG8_MMA(1, 1, At, B1); PG8_BAR; PG8_SCHED;
            PG8_LDB(B0, 1, 0); PG8_LDB(B1, 1, 1); PG8_SCHED; PG8_LDA(At, 1, 0); PG8_STAGE(PG8_SA(0, 1), a2 + hstepA, voffA);
            PG8_WAIT_V(8); PG8_WAIT_L(0); PG8_BAR; PG8_MMA(0, 0, At, B0); PG8_MMA(0, 1, At, B1); PG8_BAR; PG8_SCHED;
            PG8_LDA(At, 1, 1); PG8_STAGE(PG8_SB(1, 0), b3, voffB); PG8_STAGE(PG8_SB(1, 1), b3 + hstepB, voffB); PG8_STAGE(PG8_SA(1, 0), a3, voffA);
            PG8_WAIT_V(8); PG8_WAIT_L(0); PG8_BAR; PG8_MMA(1, 0, At, B0); PG8_MMA(1, 1, At, B1); PG8_BAR; PG8_SCHED;
        }
        if constexpr (ALIGN_EPI) { if (wr == 0) PG8_BAR; }
        if constexpr (!Epi::AFTER_DRAIN) { E(acc, cur, wr, wc, fr, fq); }
        if (!has_next) break;
#pragma unroll
        for (int a = 0; a < 2; ++a)
#pragma unroll
            for (int b = 0; b < 2; ++b)
#pragma unroll
                for (int m = 0; m < 4; ++m)
#pragma unroll
                    for (int n = 0; n < 2; ++n) acc[a][b][m][n] = (f32x4){0.f, 0.f, 0.f, 0.f};
        cur = nxt; cA = nA; cB = nB; ++ui;
        if constexpr (ALIGN_EPI) { if (wr == 1) PG8_BAR; }
    }
    PG8_WAIT_V(0);
    if constexpr (!ALIGN_EPI) { if (wr == 0) PG8_BAR; }
    PG8_BAR;
    if constexpr (Epi::AFTER_DRAIN) { E.fused(acc, cur, wr, wc, fr, fq, lds, wid, lane); }
#undef PG8_SA
#undef PG8_SB
#undef PG8_STAGE
#undef PG8_LDA
#undef PG8_LDB
#undef PG8_MMA
#undef PG8_WAIT_V
#undef PG8_WAIT_L
#undef PG8_BAR
#undef PG8_SCHED
}
}
namespace att {
#define ALAS __attribute__((address_space(3)))
typedef unsigned short bf16_t;
using bf16x8 = __attribute__((ext_vector_type(8))) short;
using s16x4 = __attribute__((ext_vector_type(4))) short;
using f32x16 = __attribute__((ext_vector_type(16))) float;
using f32x4 = __attribute__((ext_vector_type(4))) float;
using u32x4 = __attribute__((ext_vector_type(4))) unsigned;
typedef ALAS const char* lds_cptr;
typedef ALAS char* lds_ptr;
typedef short v4i16_t __attribute__((ext_vector_type(4)));
constexpr int SEQ = 4096;
constexpr float THR = 8.0f;
__device__ __forceinline__ int crow(int r, int hi) { return (r & 3) + 8 * (r >> 2) + 4 * hi; }
#define MFMA32(a, b, c) __builtin_amdgcn_mfma_f32_32x32x16_bf16(a, b, c, 0, 0, 0)
#define AWAIT_BAR(N) asm volatile("s_waitcnt vmcnt(" #N ") lgkmcnt(0)\n\ts_barrier" ::: "memory")
__device__ __forceinline__ void glds16(const void* gsrc, unsigned lds_dst) { unsigned keep;
    asm volatile("s_mov_b32 %0, m0\n\ts_mov_b32 m0, %2\n\ts_nop 0\n\tglobal_load_lds_dwordx4 %1, off\n\ts_mov_b32 m0, %0" : "=&s"(keep) : "v"(gsrc), "s"(lds_dst) : "memory"); }
typedef float f32x2_t __attribute__((ext_vector_type(2))); typedef __bf16 bf16x2_t __attribute__((ext_vector_type(2)));
__device__ __forceinline__ unsigned cvtpk(float lo, float hi) { f32x2_t v = {lo, hi}; bf16x2_t b = __builtin_convertvector(v, bf16x2_t); return __builtin_bit_cast(unsigned, b); }
__device__ __forceinline__ s16x4 vtr(lds_cptr p) { return __builtin_bit_cast(s16x4, __builtin_amdgcn_ds_read_tr16_b64_v4i16((ALAS v4i16_t*)p)); }

template <int ND0> __device__ __forceinline__ void qkt(f32x16& p0, f32x16& p1, lds_cptr kp, const bf16x8* qr, const f32x16& cinit) {
#pragma unroll
    for (int d0 = 0; d0 < ND0; ++d0) {
        const bf16x8 b0 = *(const ALAS bf16x8*)(kp + d0 * 2048);
        const bf16x8 b1 = *(const ALAS bf16x8*)(kp + d0 * 2048 + 512);
        if (d0 == 0) { p0 = MFMA32(b0, qr[0], cinit); p1 = MFMA32(b1, qr[0], cinit); }
        else { p0 = MFMA32(b0, qr[d0], p0); p1 = MFMA32(b1, qr[d0], p1); }
    }
}
__device__ __forceinline__ void pv(f32x16* o, lds_cptr vp, bf16x8 pa0, bf16x8 pa1, bf16x8 pa2, bf16x8 pa3) {
#pragma unroll
    for (int d0 = 0; d0 < 2; ++d0) {
        s16x4 lo[4], hi4[4];
#pragma unroll
        for (int ks = 0; ks < 4; ++ks) { lo[ks] = vtr(vp + d0 * 4096 + ks * 1024); hi4[ks] = vtr(vp + d0 * 4096 + ks * 1024 + 512); }
#define APK(k) (bf16x8){lo[k][0], lo[k][1], lo[k][2], lo[k][3], hi4[k][0], hi4[k][1], hi4[k][2], hi4[k][3]}
        o[d0] = MFMA32(pa0, APK(0), o[d0]);
        o[d0] = MFMA32(pa1, APK(1), o[d0]);
        o[d0] = MFMA32(pa2, APK(2), o[d0]);
        o[d0] = MFMA32(pa3, APK(3), o[d0]);
#undef APK
    }
}
struct SmState { float mhat, l; f32x16 o[2]; bool first; };
__device__ __forceinline__ void sm_pv(SmState& st, f32x16& p0, f32x16& p1, lds_cptr vp, ALAS float* wsf, int r32, int hi) {
    float a = fmaxf(fmaxf(p0[0], p0[1]), p1[0]), b = fmaxf(fmaxf(p0[2], p0[3]), p1[1]); a = fmaxf(fmaxf(a, p1[2]), p1[3]);
#pragma unroll
    for (int r = 4; r < 16; r += 4) { a = fmaxf(fmaxf(a, p0[r]), p0[r + 1]); b = fmaxf(fmaxf(b, p0[r + 2]), p0[r + 3]); a = fmaxf(fmaxf(a, p1[r]), p1[r + 1]); b = fmaxf(fmaxf(b, p1[r + 2]), p1[r + 3]); }
    float rm = fmaxf(a, b);
    { auto rr = __builtin_amdgcn_permlane32_swap(__float_as_uint(rm), __float_as_uint(rm), false, false); rm = fmaxf(__uint_as_float(rr[0]), __uint_as_float(rr[1])); }
    if (st.first) {
        st.mhat = rm;
#pragma unroll
        for (int r = 0; r < 16; ++r) { p0[r] -= rm; p1[r] -= rm; }
        st.first = false;
    } else if (__any(rm > THR)) {
        const float dl = fmaxf(rm, 0.f); st.mhat += dl;
#pragma unroll
        for (int r = 0; r < 16; ++r) { p0[r] -= dl; p1[r] -= dl; }
        const float f = __builtin_amdgcn_exp2f(-dl); st.l *= f;
        if (hi == 0) wsf[r32] = f;
        asm volatile("s_waitcnt lgkmcnt(0)" ::: "memory");
#pragma unroll
        for (int d_ = 0; d_ < 2; ++d_)
#pragma unroll
            for (int r = 0; r < 16; ++r) st.o[d_][r] *= wsf[crow(r, hi)];
    }
    float s = 0.f;
#pragma unroll
    for (int r = 0; r < 16; ++r) { p0[r] = __builtin_amdgcn_exp2f(p0[r]); p1[r] = __builtin_amdgcn_exp2f(p1[r]); s += p0[r] + p1[r]; }
    st.l += s;
    u32x4 w0 = {cvtpk(p0[0], p0[1]), cvtpk(p0[2], p0[3]), cvtpk(p0[4], p0[5]), cvtpk(p0[6], p0[7])};
    u32x4 w1 = {cvtpk(p0[8], p0[9]), cvtpk(p0[10], p0[11]), cvtpk(p0[12], p0[13]), cvtpk(p0[14], p0[15])};
    u32x4 w2 = {cvtpk(p1[0], p1[1]), cvtpk(p1[2], p1[3]), cvtpk(p1[4], p1[5]), cvtpk(p1[6], p1[7])};
    u32x4 w3 = {cvtpk(p1[8], p1[9]), cvtpk(p1[10], p1[11]), cvtpk(p1[12], p1[13]), cvtpk(p1[14], p1[15])};
    pv(st.o, vp, __builtin_bit_cast(bf16x8, w0), __builtin_bit_cast(bf16x8, w1), __builtin_bit_cast(bf16x8, w2), __builtin_bit_cast(bf16x8, w3));
}
__device__ __forceinline__ float finish_store(SmState& st, ALAS float* wsf, ALAS bf16_t* stg, bf16_t* orow0, size_t rstride, int lane, int r32, int hi) {
    float l = st.l;
    { auto rr = __builtin_amdgcn_permlane32_swap(__float_as_uint(l), __float_as_uint(l), false, false); l = __uint_as_float(rr[0]) + __uint_as_float(rr[1]); }
    if (hi == 0) wsf[32 + r32] = l;
    asm volatile("s_waitcnt lgkmcnt(0)" ::: "memory");
#pragma unroll
    for (int r = 0; r < 16; ++r) { const float rl = __builtin_amdgcn_rcpf(wsf[32 + crow(r, hi)]); const int orow = crow(r, hi);
#pragma unroll
        for (int d0 = 0; d0 < 2; ++d0) { const float v = st.o[d0][r] * rl; stg[orow * 64 + d0 * 32 + r32] = (bf16_t)(cvtpk(v, v) & 0xffffu); } }
    asm volatile("s_waitcnt lgkmcnt(0)" ::: "memory");
#pragma unroll
    for (int i = 0; i < 4; ++i) { const int row = i * 8 + (lane >> 3), ch = lane & 7; const u32x4 v = *(const ALAS u32x4*)(stg + row * 64 + ch * 8); *(u32x4*)(orow0 + (size_t)row * rstride + ch * 8) = v; }
    return st.mhat + __builtin_amdgcn_logf(l);
}

constexpr int MK_SLOT = 12288, MV_SLOT = 8192, M_LDS_K = 0, M_LDS_V = 3 * MK_SLOT, M_LDS_WS = M_LDS_V + 3 * MV_SLOT, M_LDS_OST = M_LDS_WS + 2048, M_LDS_BYTES = M_LDS_OST + 8 * 4096;
__device__ __forceinline__ void mla_unit(int b, int h, int qb, const bf16_t* QM, const bf16_t* KM, const bf16_t* VM, bf16_t* OA, lds_ptr shm, const int wave) {
    int lane_; asm volatile("v_mbcnt_lo_u32_b32 %0, -1, 0\n\tv_mbcnt_hi_u32_b32 %0, -1, %0" : "=v"(lane_));
    const int lane = lane_, r32 = lane & 31, hi = lane >> 5; const int wid = wave;
    const size_t rowb = (size_t)b * SEQ; const int q0 = qb * 256;
    const unsigned lds0 = (unsigned)(uintptr_t)shm;
    ALAS float* wsf = (ALAS float*)(shm + M_LDS_WS) + wid * 64;
    ALAS bf16_t* stg = (ALAS bf16_t*)(shm + M_LDS_OST) + wid * 2048;
    const bf16_t* ksrc = KM + (rowb + lane) * 768 + h * 96;
    const bf16_t* vsrc = VM + (rowb + 16 * (wid & 3) + (lane >> 2)) * 512 + h * 64 + (wid >> 2) * 32 + (lane & 3) * 8;
    const int NT = 4 * (qb + 1);
#define MDMA(t, sl) do { \
        glds16(ksrc + (size_t)(t) * 64 * 768 + wid * 8, (unsigned)__builtin_amdgcn_readfirstlane(lds0 + M_LDS_K + (sl) * MK_SLOT + wid * 1024)); \
        if (wid < 4) glds16(ksrc + (size_t)(t) * 64 * 768 + (8 + wid) * 8, (unsigned)__builtin_amdgcn_readfirstlane(lds0 + M_LDS_K + (sl) * MK_SLOT + (8 + wid) * 1024)); \
        glds16(vsrc + (size_t)(t) * 64 * 512, (unsigned)__builtin_amdgcn_readfirstlane(lds0 + M_LDS_V + (sl) * MV_SLOT + wid * 1024)); } while (0)
    bf16x8 qr[6];
    const bf16_t* qp = QM + (rowb + q0 + wid * 32 + r32) * 768 + h * 96 + hi * 8;
#pragma unroll
    for (int d0 = 0; d0 < 6; ++d0) qr[d0] = *(const bf16x8*)(qp + d0 * 16);
    MDMA(0, 0); MDMA(1, 1);
    SmState st; st.mhat = 0.f; st.l = 0.f; st.o[0] = f32x16{}; st.o[1] = f32x16{}; st.first = true;
    const int qw0 = q0 + wid * 32;
    const lds_cptr kp0 = (lds_cptr)shm + M_LDS_K + hi * 1024 + r32 * 16;
    const lds_cptr vp0 = (lds_cptr)shm + M_LDS_V + ((lane >> 4) & 1) * 32 + (lane & 3) * 8 + (4 * hi + ((lane & 15) >> 2)) * 64;
    int sl = 0;
    for (int t = 0; t < NT; ++t) {
        if (t + 1 < NT) { if (wid < 4) AWAIT_BAR(3); else AWAIT_BAR(2); } else AWAIT_BAR(0);
        if (t + 2 < NT) { const int s2 = (sl == 0) ? 2 : sl - 1; MDMA(t + 2, s2); }
        if (64 * t <= qw0 + 31) {
            f32x16 cinit;
#pragma unroll
            for (int r = 0; r < 16; ++r) cinit[r] = -st.mhat;
            f32x16 p0, p1;
            qkt<6>(p0, p1, kp0 + sl * MK_SLOT, qr, cinit);
            if (64 * t + 63 > qw0) {
                const int dq = qw0 + r32 - 64 * t;
#pragma unroll
                for (int r = 0; r < 16; ++r) { const int kv = crow(r, hi); if (kv > dq) p0[r] = -INFINITY; if (kv + 32 > dq) p1[r] = -INFINITY; }
            }
            sm_pv(st, p0, p1, vp0 + sl * MV_SLOT, wsf, r32, hi);
        }
        sl = (sl == 2) ? 0 : sl + 1;
    }
#undef MDMA
    (void)finish_store(st, wsf, stg, OA + (rowb + qw0) * 1024 + h * 64, 1024, lane, r32, hi);
    asm volatile("s_waitcnt lgkmcnt(0)\n\ts_barrier" ::: "memory");
}

constexpr int D_SLOT = 8192, D_LDS_K = 0, D_LDS_V = 6 * D_SLOT, D_LDS_WS = 12 * D_SLOT, D_LDS_OST = D_LDS_WS + 2048, D_LDS_BYTES = D_LDS_OST + 8 * 4096;
__device__ __forceinline__ void dil_subunit(int b, int h, int dil, int rc, int n, float cb  , const bf16_t* QD, const bf16_t* KD, const bf16_t* VD, bf16_t* DO, float* LSE, lds_ptr shm, const int wave) {
    int lane_; asm volatile("v_mbcnt_lo_u32_b32 %0, -1, 0\n\tv_mbcnt_hi_u32_b32 %0, -1, %0" : "=v"(lane_));
    const int lane = lane_, r32 = lane & 31, hi = lane >> 5; const int wid = wave;
    const size_t rowb = (size_t)b * SEQ;
    const unsigned lds0 = (unsigned)(uintptr_t)shm;
    ALAS float* wsf = (ALAS float*)(shm + D_LDS_WS) + wid * 64;
    ALAS bf16_t* stg = (ALAS bf16_t*)(shm + D_LDS_OST) + wid * 2048;
    const int tau0 = 4 * n - 2;
#pragma unroll
    for (int s = 0; s < 6; ++s) {
        const int tau = tau0 + s;
        if (tau >= 0) {
            const size_t tk = rowb + rc + (size_t)dil * (64 * tau + lane);
            glds16(KD + tk * 512 + h * 64 + wid * 8, (unsigned)__builtin_amdgcn_readfirstlane(lds0 + D_LDS_K + s * D_SLOT + wid * 1024));
            const size_t tv = rowb + rc + (size_t)dil * (64 * tau + 16 * (wid & 3) + (lane >> 2));
            glds16(VD + tv * 512 + h * 64 + (wid >> 2) * 32 + (lane & 3) * 8, (unsigned)__builtin_amdgcn_readfirstlane(lds0 + D_LDS_V + s * D_SLOT + wid * 1024));
        }
    }
    const int j0 = 256 * n + 32 * wid;
    bf16x8 qr[4];
    const bf16_t* qp = QD + (rowb + rc + (size_t)dil * (j0 + r32)) * 512 + h * 64 + hi * 8;
#pragma unroll
    for (int d0 = 0; d0 < 4; ++d0) qr[d0] = *(const bf16x8*)(qp + d0 * 16);
    SmState st; st.mhat = 0.f; st.l = 0.f; st.o[0] = f32x16{}; st.o[1] = f32x16{}; st.first = true;
    const lds_cptr kp0 = (lds_cptr)shm + D_LDS_K + hi * 1024 + r32 * 16;
    const lds_cptr vp0 = (lds_cptr)shm + D_LDS_V + ((lane >> 4) & 1) * 32 + (lane & 3) * 8 + (4 * hi + ((lane & 15) >> 2)) * 64;
    AWAIT_BAR(0);
#pragma unroll
    for (int k = 0; k < 3; ++k) {
        const int s = (wid >> 1) + k, tau = tau0 + s;
        if (tau >= 0) {
            const int dq = j0 + r32 - 64 * tau;
            const float ci = cb * (float)(4 * hi - dq) - st.mhat;
            f32x16 cinit;
#pragma unroll
            for (int r = 0; r < 16; ++r) cinit[r] = ci;
            f32x16 p0, p1;
            qkt<4>(p0, p1, kp0 + s * D_SLOT, qr, cinit);
#pragma unroll
            for (int r = 0; r < 16; ++r) { const float kc = (float)((r & 3) + 8 * (r >> 2)); p0[r] = fmaf(cb, kc, p0[r]); p1[r] = fmaf(cb, kc + 32.f, p1[r]); }
            if (k == 0) {
#pragma unroll
                for (int r = 0; r < 16; ++r) { const int kv = crow(r, hi); if (kv < dq - 128) p0[r] = -INFINITY; if (kv + 32 < dq - 128) p1[r] = -INFINITY; }
            }
            if (k == 2) {
#pragma unroll
                for (int r = 0; r < 16; ++r) { const int kv = crow(r, hi); if (kv > dq) p0[r] = -INFINITY; if (kv + 32 > dq) p1[r] = -INFINITY; }
            }
            sm_pv(st, p0, p1, vp0 + s * D_SLOT, wsf, r32, hi);
        }
    }
    const size_t orow = rowb + rc + (size_t)dil * j0;
    const float lse2 = finish_store(st, wsf, stg, DO + orow * 512 + h * 64, (size_t)dil * 512, lane, r32, hi);
    if (hi == 0) LSE[(orow + (size_t)dil * r32) * 8 + h] = lse2;
    asm volatile("s_waitcnt lgkmcnt(0)\n\ts_barrier" ::: "memory");
}
}
constexpr int NWAVES = 8;
#ifndef MK_SPLIT
#define MK_SPLIT 0
#endif
constexpr int NPHASE = 12;

constexpr int BATCH = 8, SEQ = 4096, DM = 1024, M = BATCH * SEQ, FF = 2816, NUP = 2 * FF;
constexpr float LN_EPS = 1e-5f, RMS_EPS = 1e-6f, DN_ALPHA = 1.189207115002721f;
constexpr float LOG2E = 1.4426950408889634f;
constexpr float C2M = 0.10206207261596577f * LOG2E;
constexpr float C2D = 0.125f * LOG2E;

constexpr size_t MiB = 1u << 20;
constexpr size_t WS_CTL = 0, CTL_ZERO_BYTES = 1 * MiB;
constexpr size_t WS_WIN = 2 * MiB, WS_WUQ = 6 * MiB, WS_WUKV = 7 * MiB, WS_WO = 8 * MiB, WS_WUP = 10 * MiB, WS_WDN = 21 * MiB, WS_ROPE = 27 * MiB;
constexpr size_t WS_PARTQ = 28 * MiB, WS_PARTKV = 29 * MiB, WS_LSE = 30 * MiB;
constexpr size_t WS_XB = 34 * MiB;
constexpr size_t WS_CQ = 98 * MiB;
constexpr size_t WS_CKV = 114 * MiB;
constexpr size_t WS_QD = 130 * MiB, WS_KD = 162 * MiB, WS_VD = 194 * MiB;
constexpr size_t WS_QM = 226 * MiB, WS_KM = 274 * MiB;
constexpr size_t WS_VM = 322 * MiB;
constexpr size_t WS_DO = 354 * MiB;
constexpr size_t WS_OA = 34 * MiB;
constexpr size_t WS_MIXF = 98 * MiB;
constexpr size_t WS_X1B = 226 * MiB;
constexpr size_t WS_U = 290 * MiB;
constexpr size_t WS_ACT = 34 * MiB;
constexpr size_t WS_FFNF = 290 * MiB;
constexpr size_t WS_END = 512 * MiB;
constexpr int CW_TMO = 0, CW_BAR = 4096;

constexpr int SCR_BYTES = 139264;
constexpr int LDSCTL_OFF = SCR_BYTES, MISC_OFF = LDSCTL_OFF + 320;
constexpr int LDS_BYTES = 147456;
static_assert(att::M_LDS_BYTES <= SCR_BYTES && att::D_LDS_BYTES <= SCR_BYTES && pg8::STAGE_BYTES <= SCR_BYTES && MISC_OFF + 128 <= LDS_BYTES, "LDS map");

#define GAS __attribute__((address_space(1)))
#define LAS __attribute__((address_space(3)))
typedef unsigned short bf16;
typedef unsigned v4u __attribute__((ext_vector_type(4)));
typedef unsigned v2u __attribute__((ext_vector_type(2)));
typedef float f32x4 __attribute__((ext_vector_type(4)));
typedef GAS unsigned gu32;
#define RLX_AGENT __ATOMIC_RELAXED, __HIP_MEMORY_SCOPE_AGENT
#define LDS_WAIT() asm volatile("s_waitcnt lgkmcnt(0)" ::: "memory")
#define VM_WAIT() asm volatile("s_waitcnt vmcnt(0)" ::: "memory")
__device__ __forceinline__ unsigned f2bf(float f) { unsigned u = __builtin_bit_cast(unsigned, f); return (u + 0x7fffu + ((u >> 16) & 1u)) >> 16; }
__device__ __forceinline__ unsigned pk2(float lo, float hi) { return f2bf(lo) | (f2bf(hi) << 16); }
__device__ __forceinline__ float bf2f(unsigned short b) { return __builtin_bit_cast(float, (unsigned)b << 16); }
__device__ __forceinline__ float bflo(unsigned w) { return __builtin_bit_cast(float, w << 16); }
__device__ __forceinline__ float bfhi(unsigned w) { return __builtin_bit_cast(float, w & 0xffff0000u); }

#define XB_TMO      128
#define XB_XCNT(j)  (256  + 64 * (j))
#define XB_XSUB(j)  (1280 + 64 * (j))
#define XB_XGEN(j)  (2304 + 64 * (j))
#define XB_TOP      3328
#define XB_TOPGEN   3392
#define XCD_BAR_WORDS 3456
#define XB_SPIN_CAP (1u << 18)
__device__ __forceinline__ unsigned xb_ld(unsigned* p)              { return __hip_atomic_load(p, __ATOMIC_RELAXED, __HIP_MEMORY_SCOPE_AGENT); }
__device__ __forceinline__ unsigned xb_add(unsigned* p, unsigned v) { return __hip_atomic_fetch_add(p, v, __ATOMIC_RELAXED, __HIP_MEMORY_SCOPE_AGENT); }
__device__ __forceinline__ unsigned xb_xcc_id() { return (unsigned)__builtin_amdgcn_s_getreg((3 << 11) | 20) & 0xFu; }
#define XB_SPIN(cond, bar) do { unsigned _sp = 0; while (cond) { __builtin_amdgcn_s_sleep(1); \
    if ((++_sp & 255u) == 0u) { if (xb_ld(&(bar)[XB_TMO])) break; if (_sp > XB_SPIN_CAP) { atomicAdd(&(bar)[XB_TMO], 1u); break; } } } } while (0)
struct XcdBarrier { unsigned* bar; unsigned x; volatile LAS unsigned* st; };
__device__ __forceinline__ XcdBarrier xcd_barrier_post(unsigned* bar, volatile LAS unsigned* st) {
    XcdBarrier b; b.bar = bar; b.x = xb_xcc_id(); b.st = st;
    if (threadIdx.x == 0) (void)xb_add(&bar[XB_XCNT(b.x)], 1u);
    return b;
}
__device__ __forceinline__ void xcd_barrier_complete(unsigned* bar, unsigned x, unsigned& nloc, unsigned& nx) {
    const unsigned G = gridDim.x * gridDim.y * gridDim.z;
    unsigned sum, cnt, mine, sp = 0u;
    for (;;) {
        sum = 0u; cnt = 0u; mine = 0u;
#pragma unroll
        for (unsigned j = 0; j < 16; ++j) { const unsigned c = xb_ld(&bar[XB_XCNT(j)]); sum += c; cnt += (c > 0u) ? 1u : 0u; mine = (j == x) ? c : mine; }
        if (sum == G) break;
        __builtin_amdgcn_s_sleep(1);
        if ((++sp & 255u) == 0u) { if (xb_ld(&bar[XB_TMO])) break; if (sp > XB_SPIN_CAP) { atomicAdd(&bar[XB_TMO], 1u); break; } }
    }
    nloc = mine > 0u ? mine : 1u; nx = cnt > 0u ? cnt : 1u;
}
__device__ __forceinline__ void xcd_barrier(const XcdBarrier& b) {
    asm volatile("s_waitcnt vmcnt(0)" ::: "memory");
    __syncthreads();
    if (threadIdx.x == 0) {
        unsigned* bar = b.bar;
        __builtin_amdgcn_s_waitcnt(0);
        unsigned nloc = b.st[0], nx = b.st[1];
        if (nloc == 0u) { xcd_barrier_complete(bar, b.x, nloc, nx); b.st[0] = nloc; b.st[1] = nx; }
        const unsigned old = xb_add(&bar[XB_XSUB(b.x)], 1u);
        const unsigned gen = old / nloc;
        if (old + 1u == (gen + 1u) * nloc) {
            __builtin_amdgcn_fence(__ATOMIC_RELEASE, "agent");
            asm volatile("s_waitcnt vmcnt(0)" ::: "memory");
            const unsigned og = xb_add(&bar[XB_TOP], 1u);
            const unsigned tg = og / nx;
            if (og + 1u == (tg + 1u) * nx) xb_add(&bar[XB_TOPGEN], 1u);
            else XB_SPIN(xb_ld(&bar[XB_TOPGEN]) == tg, bar);
            __builtin_amdgcn_fence(__ATOMIC_ACQUIRE, "agent");
            xb_add(&bar[XB_XGEN(b.x)], 1u);
            asm volatile("s_waitcnt vmcnt(0)" ::: "memory");
        } else {
            XB_SPIN(xb_ld(&bar[XB_XGEN(b.x)]) == gen, bar);
            __builtin_amdgcn_fence(__ATOMIC_ACQUIRE, "agent");
            asm volatile("s_waitcnt vmcnt(0)" ::: "memory");
        }
    }
    __syncthreads();
}

struct Frame {
    LAS unsigned char* lds;
    volatile LAS unsigned* MISC;
    gu32* ctl;
    int wave, vcu, G;
    const float *x, *w_in, *g_cq, *g_ckv, *w_uq, *w_uk, *w_uv, *w_o, *ln1_g, *ln1_b, *w_up, *conv_w, *conv_b, *w_down, *ln2_g, *ln2_b;
    float* out; unsigned char* ws;
};
__device__ __forceinline__ int hw_lane() { int l; asm volatile("v_mbcnt_lo_u32_b32 %0, -1, 0\n\tv_mbcnt_hi_u32_b32 %0, -1, %0" : "=v"(l)); return l; }
__device__ __forceinline__ float wave_sum(float v) {
#pragma unroll
    for (int o = 1; o < 64; o <<= 1) v += __shfl_xor(v, o);
    return v;
}
__device__ __forceinline__ void transpose_block(const float* W, int ldw, int k0, int c0, const float* ks, bf16* WT, int ldt, int r0, LAS float* scr, int lane) {
#pragma unroll 8
    for (int i = 0; i < 32; ++i) { const int kk = 2 * i + (lane >> 5); const float sc = ks ? ks[k0 + kk] : 1.f; scr[kk * 33 + (lane & 31)] = W[(size_t)(k0 + kk) * ldw + c0 + (lane & 31)] * sc; }
    LDS_WAIT(); asm volatile("" ::: "memory");
    const int c = lane & 7;
#pragma unroll
    for (int j = 0; j < 4; ++j) { const int n = (lane >> 3) + 8 * j; const LAS float* s = scr + (8 * c) * 33 + n;
        v4u o; o.x = pk2(s[0 * 33], s[1 * 33]); o.y = pk2(s[2 * 33], s[3 * 33]); o.z = pk2(s[4 * 33], s[5 * 33]); o.w = pk2(s[6 * 33], s[7 * 33]);
        *(GAS v4u*)(WT + (size_t)(r0 + n) * ldt + k0 + 8 * c) = o; }
    LDS_WAIT(); asm volatile("" ::: "memory");
}
__device__ __forceinline__ void p0_prologue(Frame& F) {
    const int lane = hw_lane();
    LAS float* scr = (LAS float*)(F.lds + F.wave * 16384);
    const int gw = F.vcu * NWAVES + F.wave, NGW = F.G * NWAVES;
    bf16* Win_t = (bf16*)(F.ws + WS_WIN); bf16* Wuq_t = (bf16*)(F.ws + WS_WUQ); bf16* Wukv_t = (bf16*)(F.ws + WS_WUKV); bf16* Wo_t = (bf16*)(F.ws + WS_WO);
    bf16* Wup_t = (bf16*)(F.ws + WS_WUP); bf16* Wdn_t = (bf16*)(F.ws + WS_WDN);
    constexpr int I_IN = 16 * 61, I_UQ = 4 * 24, I_UK = 2 * 16, I_UV = 2 * 16, I_O = 16 * 32, I_UP = 16 * 176, I_DN = 44 * 32;
    constexpr int NITEMS = I_IN + I_UQ + I_UK + I_UV + I_O + I_UP + I_DN;
    for (int it = gw; it < NITEMS; it += NGW) {
        int r = it;
        if (r < I_IN) { const int kb = r / 61, nb = r % 61, c0 = 32 * nb; transpose_block(F.w_in, 1952, 64 * kb, c0, nullptr, Win_t, 1024, c0 < 416 ? c0 : c0 + 96, scr, lane); continue; } r -= I_IN;
        if (r < I_UQ) { const int kb = r / 24, nb = r % 24; transpose_block(F.w_uq, 768, 64 * kb, 32 * nb, F.g_cq, Wuq_t, 256, 32 * nb, scr, lane); continue; } r -= I_UQ;
        if (r < I_UK) { const int kb = r / 16, nb = r % 16; transpose_block(F.w_uk, 512, 64 * kb, 32 * nb, F.g_ckv, Wukv_t, 128, 32 * nb, scr, lane); continue; } r -= I_UK;
        if (r < I_UV) { const int kb = r / 16, nb = r % 16; transpose_block(F.w_uv, 512, 64 * kb, 32 * nb, F.g_ckv, Wukv_t, 128, 512 + 32 * nb, scr, lane); continue; } r -= I_UV;
        if (r < I_O) { const int kb = r / 32, nb = r % 32; transpose_block(F.w_o, 1024, 64 * kb, 32 * nb, nullptr, Wo_t, 1024, 32 * nb, scr, lane); continue; } r -= I_O;
        if (r < I_UP) { const int kb = r / 176, nb = r % 176; const int nb2 = nb < 88 ? nb : nb - 88; const int r0 = 256 * (nb2 >> 2) + (nb < 88 ? 0 : 128) + (nb2 & 3) * 32;
            transpose_block(F.w_up, NUP, 64 * kb, 32 * nb, nullptr, Wup_t, 1024, r0, scr, lane); continue; } r -= I_UP;
        { const int kb = r / 32, nb = r % 32; transpose_block(F.w_down, 1024, 64 * kb, 32 * nb, nullptr, Wdn_t, FF, 32 * nb, scr, lane); }
    }
    { const int gt = gw * 64 + lane, NT = NGW * 64; for (int i = gt; i < 96 * 128; i += NT) *(GAS v4u*)(Win_t + (size_t)416 * 1024 + (size_t)i * 8) = (v4u){0u, 0u, 0u, 0u};
      float* rope = (float*)(F.ws + WS_ROPE);
      for (int i = gt; i < 4096 * 16; i += NT) { const int pos = i >> 4, k = i & 15; const float fr = powf(10000.0f, -(float)k / 16.0f); const float ang = (float)pos * fr; rope[2 * i] = cosf(ang); rope[2 * i + 1] = sinf(ang); } }
    bf16* XB = (bf16*)(F.ws + WS_XB);
    for (int m = gw; m < M; m += NGW) {
        const GAS f32x4* xr = (const GAS f32x4*)(F.x + (size_t)m * DM) + lane;
        GAS unsigned long long* o8 = (GAS unsigned long long*)(XB + (size_t)m * DM) + lane;
#pragma unroll
        for (int j = 0; j < 4; ++j) { const f32x4 v = xr[64 * j]; o8[64 * j] = (unsigned long long)pk2(v.x, v.y) | ((unsigned long long)pk2(v.z, v.w) << 32); }
    }
}
__device__ __forceinline__ void p2_krope(Frame& F) {
    const int lane = hw_lane();
    const bf16* CKV = (const bf16*)(F.ws + WS_CKV); bf16* KM = (bf16*)(F.ws + WS_KM); const float* rope = (const float*)(F.ws + WS_ROPE);
    const int gw = F.vcu * NWAVES + F.wave, NGW = F.G * NWAVES;
    const int rs = lane >> 5, h = (lane >> 2) & 7, q = lane & 3;
    for (int m2 = gw; m2 < M / 2; m2 += NGW) {
        const int m = 2 * m2 + rs, pos = m & 4095;
        const v4u a = *(const v4u*)(CKV + (size_t)m * 256 + 128 + 8 * (q & 1));
        const v4u b = *(const v4u*)(CKV + (size_t)m * 256 + 128 + 16 + 8 * (q & 1));
        const f32x4* tp = (const f32x4*)(rope + ((size_t)pos * 16 + 8 * (q & 1)) * 2);
        const f32x4 t0 = tp[0], t1 = tp[1], t2 = tp[2], t3 = tp[3];
        const float cs[8] = {t0[0], t0[2], t1[0], t1[2], t2[0], t2[2], t3[0], t3[2]}, sn[8] = {t0[1], t0[3], t1[1], t1[3], t2[1], t2[3], t3[1], t3[3]};
        const unsigned aw[4] = {a.x, a.y, a.z, a.w}, bw[4] = {b.x, b.y, b.z, b.w};
        float o[8];
#pragma unroll
        for (int j = 0; j < 4; ++j) {
            const float x1a = bflo(aw[j]), x1b = bfhi(aw[j]), x2a = bflo(bw[j]), x2b = bfhi(bw[j]);
            if (q < 2) { o[2 * j] = x1a * cs[2 * j] - x2a * sn[2 * j]; o[2 * j + 1] = x1b * cs[2 * j + 1] - x2b * sn[2 * j + 1]; }
            else { o[2 * j] = x1a * sn[2 * j] + x2a * cs[2 * j]; o[2 * j + 1] = x1b * sn[2 * j + 1] + x2b * cs[2 * j + 1]; }
        }
        v4u w; w.x = pk2(o[0], o[1]); w.y = pk2(o[2], o[3]); w.z = pk2(o[4], o[5]); w.w = pk2(o[6], o[7]);
        *(v4u*)(KM + (size_t)m * 768 + h * 96 + 64 + 8 * q) = w;
    }
}
__device__ __forceinline__ void p2_dilated(Frame& F) {
    const bf16* QD = (const bf16*)(F.ws + WS_QD); const bf16* KD = (const bf16*)(F.ws + WS_KD); const bf16* VD = (const bf16*)(F.ws + WS_VD);
    const int per = (3072 + F.G - 1) / F.G;
    for (int i = 0; i < per; ++i) {
        const int su = F.vcu * per + i; if (su >= 3072) break;
        const int bh = su / 48, k = su % 48, b = bh >> 3, h = bh & 7;
        int p, dil, rc, n;
        if (k < 16) { p = 0; dil = 1; rc = 0; n = k; } else if (k < 32) { p = 1; dil = 4; rc = (k - 16) >> 2; n = (k - 16) & 3; } else { p = 2; dil = 16; rc = k - 32; n = 0; }
        const float slope = __builtin_amdgcn_exp2f(-(float)(h + 1));
        att::dil_subunit(b, h, dil, rc, n, slope * (float)dil * LOG2E, QD, KD, VD, (bf16*)(F.ws + WS_DO) + (size_t)p * M * 512, (float*)(F.ws + WS_LSE) + (size_t)p * M * 8, (att::lds_ptr)F.lds, F.wave);
    }
}
__device__ __forceinline__ void p3_mla(Frame& F) {
    const bf16* QM = (const bf16*)(F.ws + WS_QM); const bf16* KM = (const bf16*)(F.ws + WS_KM); const bf16* VM = (const bf16*)(F.ws + WS_VM); bf16* OA = (bf16*)(F.ws + WS_OA);
    if (F.G == 256) {
        const int bh = F.vcu >> 2, s = F.vcu & 3;
        for (int i = 0; i < 4; ++i) { const int qb = (i == 0) ? 15 - s : (i == 1) ? 8 + s : (i == 2) ? 7 - s : s; att::mla_unit(bh >> 3, bh & 7, qb, QM, KM, VM, OA, (att::lds_ptr)F.lds, F.wave); }
    } else {
        for (int u = F.vcu; u < 1024; u += F.G) att::mla_unit(u >> 7, (u >> 4) & 7, u & 15, QM, KM, VM, OA, (att::lds_ptr)F.lds, F.wave);
    }
}
__device__ __forceinline__ void p3_combine(Frame& F) {
    const int lane = hw_lane();
    const bf16* DO = (const bf16*)(F.ws + WS_DO); const float* LSE = (const float*)(F.ws + WS_LSE); bf16* OA = (bf16*)(F.ws + WS_OA);
    const int gw = F.vcu * NWAVES + F.wave, NGW = F.G * NWAVES, h = lane >> 3;
    for (int m = gw; m < M; m += NGW) {
        const float l0 = LSE[(size_t)m * 8 + h], l1 = LSE[(size_t)M * 8 + (size_t)m * 8 + h], l2 = LSE[(size_t)2 * M * 8 + (size_t)m * 8 + h];
        const float mx = fmaxf(fmaxf(l0, l1), l2);
        float w0 = __builtin_amdgcn_exp2f(l0 - mx), w1 = __builtin_amdgcn_exp2f(l1 - mx), w2 = __builtin_amdgcn_exp2f(l2 - mx);
        const float inv = 1.0f / (w0 + w1 + w2); w0 *= inv; w1 *= inv; w2 *= inv;
        const v4u a = *(const v4u*)(DO + (size_t)m * 512 + lane * 8), b = *(const v4u*)(DO + (size_t)M * 512 + (size_t)m * 512 + lane * 8), c = *(const v4u*)(DO + (size_t)2 * M * 512 + (size_t)m * 512 + lane * 8);
        const unsigned aw[4] = {a.x, a.y, a.z, a.w}, bw[4] = {b.x, b.y, b.z, b.w}, cw[4] = {c.x, c.y, c.z, c.w};
        unsigned ow[4];
#pragma unroll
        for (int j = 0; j < 4; ++j) ow[j] = pk2(w0 * bflo(aw[j]) + w1 * bflo(bw[j]) + w2 * bflo(cw[j]), w0 * bfhi(aw[j]) + w1 * bfhi(bw[j]) + w2 * bfhi(cw[j]));
        *(v4u*)(OA + (size_t)m * 1024 + 512 + lane * 8) = (v4u){ow[0], ow[1], ow[2], ow[3]};
    }
}
__device__ __forceinline__ void ln_phase(Frame& F, const float* xin, const float* add, const float* g, const float* bb, float* outf, bf16* outb) {
    const int lane = hw_lane();
    const int gw = F.vcu * NWAVES + F.wave, NGW = F.G * NWAVES;
    for (int m = gw; m < M; m += NGW) {
        const f32x4* xr = (const f32x4*)(xin + (size_t)m * DM) + lane; const f32x4* ar = (const f32x4*)(add + (size_t)m * DM) + lane;
        f32x4 v[4]; float s = 0.f;
#pragma unroll
        for (int j = 0; j < 4; ++j) { v[j] = xr[64 * j] * DN_ALPHA + ar[64 * j]; s += (v[j].x + v[j].y) + (v[j].z + v[j].w); }
        const float mean = wave_sum(s) * (1.f / DM); float s2 = 0.f;
#pragma unroll
        for (int j = 0; j < 4; ++j) { v[j] = v[j] - mean; s2 += (v[j].x * v[j].x + v[j].y * v[j].y) + (v[j].z * v[j].z + v[j].w * v[j].w); }
        const float rstd = 1.f / sqrtf(wave_sum(s2) * (1.f / DM) + LN_EPS);
#pragma unroll
        for (int j = 0; j < 4; ++j) { const f32x4 gg = ((const f32x4*)g)[lane + 64 * j], be = ((const f32x4*)bb)[lane + 64 * j]; const f32x4 o = v[j] * rstd * gg + be;
            ((f32x4*)(outf + (size_t)m * DM))[lane + 64 * j] = o;
            if (outb) ((unsigned long long*)(outb + (size_t)m * DM))[lane + 64 * j] = (unsigned long long)pk2(o.x, o.y) | ((unsigned long long)pk2(o.z, o.w) << 32); }
    }
}
__device__ __forceinline__ float gelu_tanh(float x) { const float u = 0.7978845608028654f * (x + 0.044715f * x * x * x); const float e = __builtin_amdgcn_exp2f(2.0f * LOG2E * u); return x * (1.0f - 1.0f / (e + 1.0f)); }
__device__ __forceinline__ void conv_phase(Frame& F, int row0, int nrows) {
    const int lane = hw_lane();
    const bf16* U = (const bf16*)(F.ws + WS_U); bf16* ACT = (bf16*)(F.ws + WS_ACT);
    const size_t gt = (size_t)(F.vcu * NWAVES + F.wave) * 64 + lane, NT = (size_t)F.G * NWAVES * 64;
    for (size_t it = gt; it < (size_t)nrows * 352; it += NT) {
        const int lr = (int)(it / 352), cc = (int)(it % 352), ac = cc * 8;
        const int pn = ac >> 7, j0 = ac & 127, t = (row0 + lr) & 4095;
        float ya[8], yg[8];
#pragma unroll
        for (int e = 0; e < 8; ++e) { ya[e] = F.conv_b[ac + e]; yg[e] = F.conv_b[FF + ac + e]; }
#pragma unroll
        for (int tap = 0; tap < 3; ++tap) {
            const int sh = 2 - tap;
            if (t - sh >= 0) {
                const bf16* up = U + (size_t)(lr - sh) * NUP + pn * 256 + j0;
                const v4u a = *(const v4u*)up, g = *(const v4u*)(up + 128);
                const unsigned aw[4] = {a.x, a.y, a.z, a.w}, gw_[4] = {g.x, g.y, g.z, g.w};
#pragma unroll
                for (int e = 0; e < 4; ++e) {
                    ya[2 * e] = fmaf(F.conv_w[tap * NUP + ac + 2 * e], bflo(aw[e]), ya[2 * e]); ya[2 * e + 1] = fmaf(F.conv_w[tap * NUP + ac + 2 * e + 1], bfhi(aw[e]), ya[2 * e + 1]);
                    yg[2 * e] = fmaf(F.conv_w[tap * NUP + FF + ac + 2 * e], bflo(gw_[e]), yg[2 * e]); yg[2 * e + 1] = fmaf(F.conv_w[tap * NUP + FF + ac + 2 * e + 1], bfhi(gw_[e]), yg[2 * e + 1]);
                }
            }
        }
        v4u w; w.x = pk2(gelu_tanh(yg[0]) * ya[0], gelu_tanh(yg[1]) * ya[1]); w.y = pk2(gelu_tanh(yg[2]) * ya[2], gelu_tanh(yg[3]) * ya[3]);
        w.z = pk2(gelu_tanh(yg[4]) * ya[4], gelu_tanh(yg[5]) * ya[5]); w.w = pk2(gelu_tanh(yg[6]) * ya[6], gelu_tanh(yg[7]) * ya[7]);
        *(v4u*)(ACT + (size_t)(row0 + lr) * FF + ac) = w;
    }
}

struct Args { const float* in[16]; float* out; unsigned char* ws; int ph_lo, ph_hi; };
__global__ void __launch_bounds__(NWAVES * 64, 2) mk_fwd(Args args) {
    extern __shared__ __attribute__((aligned(16))) unsigned char lds[];
    Frame F;
    F.lds = (LAS unsigned char*)lds;
    F.MISC = (volatile LAS unsigned*)(F.lds + MISC_OFF);
    F.wave = __builtin_amdgcn_readfirstlane((int)threadIdx.x >> 6);
    F.G = gridDim.x; { const int bx = blockIdx.x; F.vcu = (F.G % 8 == 0) ? (bx % 8) * (F.G / 8) + bx / 8 : bx; }
    F.ws = args.ws; F.out = args.out; F.ctl = (gu32*)(args.ws + WS_CTL);
    F.x = args.in[0]; F.w_in = args.in[1]; F.g_cq = args.in[2]; F.g_ckv = args.in[3]; F.w_uq = args.in[4]; F.w_uk = args.in[5]; F.w_uv = args.in[6]; F.w_o = args.in[7];
    F.ln1_g = args.in[8]; F.ln1_b = args.in[9]; F.w_up = args.in[10]; F.conv_w = args.in[11]; F.conv_b = args.in[12]; F.w_down = args.in[13]; F.ln2_g = args.in[14]; F.ln2_b = args.in[15];
    for (int u = threadIdx.x; u < (LDS_BYTES - LDSCTL_OFF) / 4; u += NWAVES * 64) ((LAS unsigned*)(F.lds + LDSCTL_OFF))[u] = 0u;
    __syncthreads();
    XcdBarrier bar; bar.bar = (unsigned*)(F.ctl + CW_BAR); bar.x = 0; bar.st = nullptr;
    if (!MK_SPLIT) bar = xcd_barrier_post((unsigned*)(F.ctl + CW_BAR), F.MISC + 8);
    const int lo = args.ph_lo, hi = args.ph_hi;
#ifndef PHASE_MASK
#define PHASE_MASK 0xFFF
#endif
#define IN(k) (((PHASE_MASK >> (k)) & 1) && lo <= (k) && (k) < hi)
#define SEAM(k) do { if (IN(k) && IN((k) + 1)) xcd_barrier(bar); } while (0)
    bf16* Win_t = (bf16*)(F.ws + WS_WIN); bf16* Wuq_t = (bf16*)(F.ws + WS_WUQ); bf16* Wukv_t = (bf16*)(F.ws + WS_WUKV); bf16* Wo_t = (bf16*)(F.ws + WS_WO);
    bf16* Wup_t = (bf16*)(F.ws + WS_WUP); bf16* Wdn_t = (bf16*)(F.ws + WS_WDN);
    if (IN(0)) { p0_prologue(F); } SEAM(0);
    if (IN(1)) {
        pg8::Gemm g{(const bf16*)(F.ws + WS_XB), Win_t, M, 2048, DM, DM, DM}; pg8::StaticOrder S; S.init(M, 2048, F.G, (int)blockIdx.x);
        pg8::EpiH E{(bf16*)(F.ws + WS_CQ), (bf16*)(F.ws + WS_CKV), (bf16*)(F.ws + WS_QD), (bf16*)(F.ws + WS_KD), (bf16*)(F.ws + WS_VD), (float*)(F.ws + WS_PARTQ), (float*)(F.ws + WS_PARTKV), C2D};
        pg8::gemm_phase<pg8::EpiH, pg8::StaticOrder, true>(F.lds, g, S, E, F.wave);
    } SEAM(1);
    if (IN(2)) {
#ifndef P2SUB
#define P2SUB 15
#endif
        if (P2SUB & 1) { pg8::Gemm g{(const bf16*)(F.ws + WS_CQ), Wuq_t, M, 768, 256, 256, 256}; pg8::StaticOrder S; S.init(M, 768, F.G, (int)blockIdx.x);
          pg8::EpiQ E{(bf16*)(F.ws + WS_QM), (const float*)(F.ws + WS_PARTQ), (const float*)(F.ws + WS_ROPE), C2M, RMS_EPS};
          pg8::gemm_phase<pg8::EpiQ, pg8::StaticOrder, true>(F.lds, g, S, E, F.wave); }
        if (P2SUB & 2) { pg8::Gemm g{(const bf16*)(F.ws + WS_CKV), Wukv_t, M, 1024, 128, 256, 128}; pg8::StaticOrder S; S.init(M, 1024, F.G, (int)blockIdx.x);
          pg8::EpiKV E{(bf16*)(F.ws + WS_KM), (bf16*)(F.ws + WS_VM), (const float*)(F.ws + WS_PARTKV), RMS_EPS};
          pg8::gemm_phase<pg8::EpiKV, pg8::StaticOrder, true>(F.lds, g, S, E, F.wave); }
        if (P2SUB & 4) p2_krope(F);
        if (P2SUB & 8) p2_dilated(F);
    } SEAM(2);
    if (IN(3)) { p3_mla(F); p3_combine(F); } SEAM(3);
    if (IN(4)) {
        pg8::Gemm g{(const bf16*)(F.ws + WS_OA), Wo_t, M, DM, DM, DM, DM}; pg8::StaticOrder S; S.init(M, DM, F.G, (int)blockIdx.x);
        pg8::EpiStoreF32 E{(float*)(F.ws + WS_MIXF), DM};
        pg8::gemm_phase<pg8::EpiStoreF32, pg8::StaticOrder, true>(F.lds, g, S, E, F.wave);
    } SEAM(4);
    if (IN(5)) { ln_phase(F, F.x, (const float*)(F.ws + WS_MIXF), F.ln1_g, F.ln1_b, F.out, (bf16*)(F.ws + WS_X1B)); } SEAM(5);
    for (int hf = 0; hf < 2; ++hf) {
        if (IN(6 + 2 * hf)) {
            pg8::Gemm g{(const bf16*)(F.ws + WS_X1B) + (size_t)hf * (M / 2) * DM, Wup_t, M / 2, NUP, DM, DM, DM}; pg8::StaticOrder S; S.init(M / 2, NUP, F.G, (int)blockIdx.x);
            pg8::EpiStoreBf16 E{(bf16*)(F.ws + WS_U), NUP};
            pg8::gemm_phase<pg8::EpiStoreBf16, pg8::StaticOrder, true>(F.lds, g, S, E, F.wave);
        } SEAM(6 + 2 * hf);
        if (IN(7 + 2 * hf)) { conv_phase(F, hf * (M / 2), M / 2); } SEAM(7 + 2 * hf);
    }
    if (IN(10)) {
        pg8::Gemm g{(const bf16*)(F.ws + WS_ACT), Wdn_t, M, DM, FF, FF, FF}; pg8::StaticOrder S; S.init(M, DM, F.G, (int)blockIdx.x);
        pg8::EpiStoreF32 E{(float*)(F.ws + WS_FFNF), DM};
        pg8::gemm_phase<pg8::EpiStoreF32, pg8::StaticOrder, true>(F.lds, g, S, E, F.wave);
    } SEAM(10);
    if (IN(11)) { ln_phase(F, F.out, (const float*)(F.ws + WS_FFNF), F.ln2_g, F.ln2_b, F.out, nullptr); }
#undef IN
#undef SEAM
}

extern "C" void kernel_launch(void* const* d_in, const int* in_sizes, int n_in, void* d_out, int out_size, void* d_ws, size_t ws_size, hipStream_t stream) {
    static int grid = 0;
    if (grid == 0) {
        if (n_in != 16 || in_sizes[0] != M * DM || out_size != M * DM || ws_size < WS_END) { fprintf(stderr, "kernel_launch: unexpected shapes (n_in %d, ws %zu); nothing launched\n", n_in, ws_size); grid = -1; return; }
        int dev = 0, cus = 0;
        if (hipGetDevice(&dev) != hipSuccess || hipDeviceGetAttribute(&cus, hipDeviceAttributeMultiprocessorCount, dev) != hipSuccess) { grid = -1; return; }
        if (hipFuncSetAttribute((const void*)mk_fwd, hipFuncAttributeMaxDynamicSharedMemorySize, LDS_BYTES) != hipSuccess) { fprintf(stderr, "kernel_launch: hipFuncSetAttribute failed\n"); grid = -1; return; }
        (void)hipGetLastError();
        grid = cus;
    }
    if (grid < 0) return;
    if (hipMemsetAsync((char*)d_ws + WS_CTL, 0, CTL_ZERO_BYTES, stream) != hipSuccess) return;
    Args a{};
    for (int i = 0; i < 16; ++i) a.in[i] = (const float*)d_in[i];
    a.out = (float*)d_out; a.ws = (unsigned char*)d_ws;
    const int nl = MK_SPLIT ? NPHASE : 1;
    for (int li = 0; li < nl; ++li) {
        a.ph_lo = MK_SPLIT ? li : 0; a.ph_hi = MK_SPLIT ? li + 1 : NPHASE;
        hipLaunchKernelGGL(mk_fwd, dim3(grid), dim3(NWAVES * 64), LDS_BYTES, stream, a);
        if (hipPeekAtLastError() != hipSuccess) { fprintf(stderr, "kernel_launch: launch %d failed\n", li); break; }
    }
}
```
